# Optimizing an MI355X kernel written in HIP

```python
import math
import jax, jax.numpy as jnp
from jax import lax
import numpy as np

D_MODEL = 1024
BATCH = 4
SEQ = 4096
DEPTH = 2

GRID_W = 64
CTX_LEN = 256
EPS = 1e-6
N_BRANCH = 4
POOL_W = 256
POOL_GROUPS = 4
POOL_WINDOWS = (2, 4, 8, 16)
SSM_W = 256
SSM_CH = 16
SSM_GROUPS = SSM_W // SSM_CH
SSM_N = 64
DT_MIN = 1e-3
DT_MAX = 1e-1
GMLP_W = 256
GMLP_HEADS = 4
CHUNK = 128
NA_HEADS = 4
HEAD_DIM = 64
NA_W = NA_HEADS * HEAD_DIM
WIN_ROWS = 8
WIN_COLS = 16
ROPE_BASE = 10000.0
BRANCH_W = 256
IN_W = POOL_W + SSM_W + 2 * GMLP_W + 3 * NA_W
N_EXPERTS = 32
TOP_K = 4
D_EXPERT = 1024
SWIGLU_LIMIT = 7.0
SWIGLU_ALPHA = 1.702
MOE_BLOCK = 128

kernel_name = 'hybrid_pool_s5_gmlp_natten_moe_dit'

F32 = jnp.float32


def rmsnorm(x, g):
    xf = x.astype(F32)
    return (xf * lax.rsqrt(jnp.mean(xf * xf, axis=-1, keepdims=True) + EPS) * g.astype(F32)).astype(x.dtype)


def layernorm(x, g, b):
    xf = x.astype(F32)
    mu = jnp.mean(xf, axis=-1, keepdims=True)
    var = jnp.mean((xf - mu) ** 2, axis=-1, keepdims=True)
    return ((xf - mu) * lax.rsqrt(var + EPS) * g.astype(F32) + b.astype(F32)).astype(x.dtype)


def modulate(h, shift, scale):
    return h * (1.0 + scale) + shift


def axial_rope(x):
    L_ = x.shape[1]
    t = jnp.arange(L_)
    half = HEAD_DIM // 2
    nf = half // 2
    inv = ROPE_BASE ** (-jnp.arange(nf, dtype=F32) / nf)
    xf = x.astype(F32)

    def rot(xp, pos):
        ang = pos.astype(F32)[:, None] * inv
        cos = jnp.cos(ang)[None, :, None, :]
        sin = jnp.sin(ang)[None, :, None, :]
        x1, x2 = xp[..., :nf], xp[..., nf:]
        return jnp.concatenate([x1 * cos - x2 * sin, x2 * cos + x1 * sin], axis=-1)

    return jnp.concatenate([rot(xf[..., :half], t // GRID_W), rot(xf[..., half:], t % GRID_W)], axis=-1).astype(x.dtype)


def pool_mix(u, w_pool, pool_scale):
    B_, L_, _ = u.shape
    cg = POOL_W // POOL_GROUPS
    uf = u.reshape(B_, L_, POOL_GROUPS, cg).astype(F32)
    cs = jnp.concatenate([jnp.zeros_like(uf[:, :1]), jnp.cumsum(uf, axis=1)], axis=1)
    win = jnp.asarray(POOL_WINDOWS, jnp.int32)
    t = jnp.arange(L_, dtype=jnp.int32)[:, None]
    lo = jnp.clip(t - win // 2, 0, L_)
    hi = jnp.clip(t - win // 2 + win, 0, L_)
    gi = jnp.arange(POOL_GROUPS)
    mean = (cs[:, hi, gi] - cs[:, lo, gi]) / (hi - lo).astype(F32)[None, :, :, None]
    p = (mean - uf).astype(u.dtype)
    y = jnp.einsum('blgc,gcd->blgd', p, w_pool).reshape(B_, L_, POOL_W)
    return y * pool_scale


def diag_scan(a_bar, bu, h0, reverse):
    edge = -1 if reverse else 0
    bu = bu.at[:, edge].add(a_bar * h0)
    a = jnp.broadcast_to(a_bar, bu.shape)

    def combine(e1, e2):
        a1, b1 = e1
        a2, b2 = e2
        return a1 * a2, a2 * b1 + b2

    _, h = lax.associative_scan(combine, (a, bu), reverse=reverse, axis=1)
    return h


def s5_mix(u_l, u_c, a_re, a_im, log_dt, b_re, b_im, c_re, c_im, d, w_glu, with_ctx_out):
    a = lax.complex(a_re.astype(F32), a_im.astype(F32))
    a_bar = jnp.exp(a * jnp.exp(log_dt.astype(F32))[..., None])
    b_bar = ((a_bar - 1.0) / a)[..., None] * lax.complex(b_re.astype(F32), b_im.astype(F32))
    cm = lax.complex(c_re.astype(F32), c_im.astype(F32))

    def drive(u):
        B_, L_ = u.shape[:2]
        ug = u.reshape(B_, L_, SSM_GROUPS, SSM_CH).astype(F32).astype(jnp.complex64)
        return jnp.einsum('blgp,sgnp->sblgn', ug, b_bar)

    bu_c = drive(u_c)
    bu_l = drive(u_l)
    zero = jnp.zeros((u_c.shape[0], SSM_GROUPS, SSM_N), jnp.complex64)
    hf_c = diag_scan(a_bar[0], bu_c[0], zero, False)
    hb_c = diag_scan(a_bar[1], bu_c[1], zero, True)
    hf_l = diag_scan(a_bar[0], bu_l[0], hf_c[:, -1], False)
    hb_l = diag_scan(a_bar[1], bu_l[1], hb_c[:, 0], True)

    def readout(hf, hb, u):
        B_, L_ = u.shape[:2]
        y = (jnp.einsum('blgn,gpn->blgp', hf, cm[0]) + jnp.einsum('blgn,gpn->blgp', hb, cm[1])).real
        y = y.reshape(B_, L_, SSM_W).astype(u.dtype) + d * u
        y = jax.nn.gelu(y)
        z = y @ w_glu
        return z[..., :SSM_W] * jax.nn.sigmoid(z[..., SSM_W:])

    y_l = readout(hf_l, hb_l, u_l)
    y_c = readout(hf_c, hb_c, u_c) if with_ctx_out else None
    return y_l, y_c


def gmlp_mix(p, ln_g, ln_b, w_s, b_s):
    B_, L_, _ = p.shape
    uv = jax.nn.gelu(p)
    u = uv[..., :GMLP_W]
    v = layernorm(uv[..., GMLP_W:], ln_g, ln_b)
    vc = v.reshape(B_, L_ // CHUNK, CHUNK, GMLP_HEADS, GMLP_W // GMLP_HEADS)
    sv = jnp.einsum('hpq,bnqhc->bnphc', w_s, vc) + b_s.T[None, None, :, :, None]
    return u * sv.reshape(B_, L_, GMLP_W)


def neighbourhood_attention(q, k, v, k_ctx, v_ctx, rpb):
    B_, L_, H, dh = q.shape
    rows = L_ // GRID_W
    wr = min(WIN_ROWS, rows)
    wc = WIN_COLS
    qg = q.reshape(B_, rows, GRID_W, H, dh)
    kg = k.reshape(B_, rows, GRID_W, H, dh)
    vg = v.reshape(B_, rows, GRID_W, H, dh)
    ci = jnp.arange(GRID_W)
    col_start = jnp.clip(ci - wc // 2, 0, GRID_W - wc)
    col_idx = col_start[:, None] + jnp.arange(wc)[None, :]
    col_off = col_idx - ci[:, None] + (WIN_COLS - 1)
    n_nb = wr * wc

    def row_block(r):
        rs = jnp.clip(r - wr // 2, 0, rows - wr)
        k_rows = lax.dynamic_slice_in_dim(kg, rs, wr, axis=1)
        v_rows = lax.dynamic_slice_in_dim(vg, rs, wr, axis=1)
        k_nb = k_rows[:, :, col_idx]
        v_nb = v_rows[:, :, col_idx]
        q_r = lax.dynamic_index_in_dim(qg, r, axis=1, keepdims=False)
        row_off = rs + jnp.arange(wr) - r + (WIN_ROWS - 1)
        bias = rpb[:, row_off[None, :, None], col_off[:, None, :]]
        s_nb = jnp.einsum('bqhd,bjqkhd->bhqjk', q_r, k_nb).astype(F32) + bias.astype(F32)[None]
        s_ctx = jnp.einsum('bqhd,bkhd->bhqk', q_r, k_ctx).astype(F32)
        s = jnp.concatenate([s_nb.reshape(B_, H, GRID_W, n_nb), s_ctx], axis=-1)
        pr = jax.nn.softmax(s, axis=-1).astype(q.dtype)
        p_nb = pr[..., :n_nb].reshape(B_, H, GRID_W, wr, wc)
        p_ctx = pr[..., n_nb:]
        return (jnp.einsum('bhqjk,bjqkhd->bqhd', p_nb, v_nb)
                + jnp.einsum('bhqk,bkhd->bqhd', p_ctx, v_ctx))

    out = lax.map(row_block, jnp.arange(rows))
    return out.transpose(1, 0, 2, 3, 4).reshape(B_, L_, H * dh)


def context_attention(q, k, v):
    B_, Lc, H, dh = q.shape
    s = jnp.einsum('bqhd,bkhd->bhqk', q, k).astype(F32)
    pr = jax.nn.softmax(s, axis=-1).astype(q.dtype)
    return jnp.einsum('bhqk,bkhd->bqhd', pr, v).reshape(B_, Lc, H * dh)


def split_in(p):
    o1 = POOL_W
    o2 = o1 + SSM_W
    o3 = o2 + 2 * GMLP_W
    B_, L_ = p.shape[:2]
    qkv = p[..., o3:].reshape(B_, L_, 3, NA_HEADS, HEAD_DIM)
    return p[..., :o1], p[..., o1:o2], p[..., o2:o3], qkv[:, :, 0], qkv[:, :, 1], qkv[:, :, 2]


def merge_branches(h, branches, w_bg, b_bg, w_br, w_out):
    br = jnp.stack(branches, axis=-2)
    proj = jnp.einsum('blic,icd->blid', br, w_br)
    gates = jax.nn.sigmoid(h @ w_bg + b_bg).reshape(proj.shape)
    return jnp.sum(gates * proj, axis=-2) @ w_out


def token_mixers(hl, hc, w_in, w_bg, b_bg, w_br, w_out, pool_w, pool_scale,
                 a_re, a_im, log_dt, b_re, b_im, c_re, c_im, d, w_glu,
                 ln_g, ln_b, w_s, b_s, rpb, with_ctx_out):
    pa_l, pb_l, pg_l, q_l, k_l, v_l = split_in(hl @ w_in)
    pa_c, pb_c, pg_c, q_c, k_c, v_c = split_in(hc @ w_in)
    qscale = HEAD_DIM ** -0.5
    q_l = axial_rope(q_l) * qscale
    k_l = axial_rope(k_l)
    ya_l = pool_mix(pa_l, pool_w, pool_scale)
    yb_l, yb_c = s5_mix(pb_l, pb_c, a_re, a_im, log_dt, b_re, b_im, c_re, c_im, d, w_glu, with_ctx_out)
    yg_l = gmlp_mix(pg_l, ln_g, ln_b, w_s, b_s)
    yd_l = neighbourhood_attention(q_l, k_l, v_l, k_c, v_c, rpb)
    out_l = merge_branches(hl, [ya_l, yb_l, yg_l, yd_l], w_bg, b_bg, w_br, w_out)
    if not with_ctx_out:
        return out_l, None
    ya_c = pool_mix(pa_c, pool_w, pool_scale)
    yg_c = gmlp_mix(pg_c, ln_g, ln_b, w_s, b_s)
    yd_c = context_attention(q_c * qscale, k_c, v_c)
    out_c = merge_branches(hc, [ya_c, yb_c, yg_c, yd_c], w_bg, b_bg, w_br, w_out)
    return out_l, out_c


def moe(x, w_router, b_router, w1, b1, w2, b2):
    T, D = x.shape
    logits = (x @ w_router).astype(F32) + b_router.astype(F32)
    top_v, top_i = lax.top_k(logits, TOP_K)
    wts = jax.nn.softmax(top_v, axis=-1)
    A = T * TOP_K
    flat_e = top_i.reshape(A)
    flat_t = jnp.arange(A, dtype=jnp.int32) // TOP_K
    flat_w = wts.reshape(A)
    order = jnp.argsort(flat_e)
    e_sorted = flat_e[order]
    counts = jnp.bincount(flat_e, length=N_EXPERTS)
    padded = (counts + MOE_BLOCK - 1) // MOE_BLOCK * MOE_BLOCK
    start = jnp.cumsum(counts) - counts
    pend = jnp.cumsum(padded)
    pstart = pend - padded
    dest = pstart[e_sorted] + (jnp.arange(A) - start[e_sorted])
    n_blocks = (A + N_EXPERTS * (MOE_BLOCK - 1) + MOE_BLOCK - 1) // MOE_BLOCK
    P = n_blocks * MOE_BLOCK
    tok_sorted = flat_t[order]
    row_tok = jnp.full((P,), T, jnp.int32).at[dest].set(tok_sorted)
    x_pad = jnp.concatenate([x, jnp.zeros((1, D), x.dtype)], axis=0)
    xb = x_pad[row_tok].reshape(n_blocks, MOE_BLOCK, D)
    block_e = jnp.minimum(jnp.searchsorted(pend, jnp.arange(n_blocks) * MOE_BLOCK, side='right'), N_EXPERTS - 1)

    def expert_block(args):
        xblk, e = args
        h = xblk @ w1[e] + b1[e]
        g = jnp.minimum(h[..., :D_EXPERT], SWIGLU_LIMIT)
        lin = jnp.clip(h[..., D_EXPERT:], -SWIGLU_LIMIT, SWIGLU_LIMIT)
        act = g * jax.nn.sigmoid(SWIGLU_ALPHA * g) * (lin + 1.0)
        return act @ w2[e] + b2[e]

    yb = lax.map(expert_block, (xb, block_e)).reshape(P, D)
    y_assign = yb[dest] * flat_w[order][:, None].astype(yb.dtype)
    return jnp.zeros((T, D), x.dtype).at[tok_sorted].add(y_assign)


def setup_inputs(seed: int = 0) -> dict:
    key = jax.random.key(seed)
    ks = iter(jax.random.split(key, 48))
    D = D_MODEL

    def nrm(shape, scale):
        return scale * jax.random.normal(next(ks), shape, F32)

    a_im_base = math.pi * jnp.arange(SSM_N, dtype=F32)
    return {
        'x': nrm((BATCH, SEQ, D), 1.0),
        'c': nrm((BATCH, D), 1.0),
        'ctx': nrm((BATCH, CTX_LEN, D), 1.0),
        'c_ctx': nrm((D,), 1.0),
        'ada_w': nrm((DEPTH, D, 6 * D), 0.5 * D ** -0.5),
        'ada_b': nrm((DEPTH, 6 * D), 0.02),
        'norm_mix_pre': 1.0 + nrm((DEPTH, D), 0.02),
        'norm_mix_post': 1.0 + nrm((DEPTH, D), 0.02),
        'norm_ffn_pre': 1.0 + nrm((DEPTH, D), 0.02),
        'norm_ffn_post': 1.0 + nrm((DEPTH, D), 0.02),
        'w_in': nrm((DEPTH, D, IN_W), D ** -0.5),
        'w_branch_gate': nrm((DEPTH, D, N_BRANCH * D), D ** -0.5),
        'b_branch_gate': nrm((DEPTH, N_BRANCH * D), 0.02),
        'w_branch': nrm((DEPTH, N_BRANCH, BRANCH_W, D), BRANCH_W ** -0.5),
        'w_out': nrm((DEPTH, D, D), D ** -0.5),
        'pool_w': nrm((DEPTH, POOL_GROUPS, POOL_W // POOL_GROUPS, POOL_W // POOL_GROUPS), (POOL_W // POOL_GROUPS) ** -0.5),
        'pool_scale': 1.0 + nrm((DEPTH, POOL_W), 0.02),
        'ssm_a_re': -0.5 + nrm((DEPTH, 2, SSM_GROUPS, SSM_N), 0.01),
        'ssm_a_im': a_im_base + nrm((DEPTH, 2, SSM_GROUPS, SSM_N), 0.01),
        'ssm_log_dt': jax.random.uniform(next(ks), (DEPTH, 2, SSM_GROUPS), F32, math.log(DT_MIN), math.log(DT_MAX)),
        'ssm_b_re': nrm((DEPTH, 2, SSM_GROUPS, SSM_N, SSM_CH), SSM_CH ** -0.5),
        'ssm_b_im': nrm((DEPTH, 2, SSM_GROUPS, SSM_N, SSM_CH), SSM_CH ** -0.5),
        'ssm_c_re': nrm((DEPTH, 2, SSM_GROUPS, SSM_CH, SSM_N), 0.5),
        'ssm_c_im': nrm((DEPTH, 2, SSM_GROUPS, SSM_CH, SSM_N), 0.5),
        'ssm_d': nrm((DEPTH, SSM_W), 1.0),
        'ssm_w_glu': nrm((DEPTH, SSM_W, 2 * SSM_W), SSM_W ** -0.5),
        'gmlp_ln_g': 1.0 + nrm((DEPTH, GMLP_W), 0.02),
        'gmlp_ln_b': nrm((DEPTH, GMLP_W), 0.02),
        'gmlp_w_s': nrm((DEPTH, GMLP_HEADS, CHUNK, CHUNK), CHUNK ** -0.5),
        'gmlp_b_s': 1.0 + nrm((DEPTH, GMLP_HEADS, CHUNK), 0.02),
        'na_rpb': nrm((DEPTH, NA_HEADS, 2 * WIN_ROWS - 1, 2 * WIN_COLS - 1), 0.1),
        'router_w': nrm((DEPTH, D, N_EXPERTS), D ** -0.5),
        'router_b': nrm((DEPTH, N_EXPERTS), 0.01),
        'expert_w1': nrm((DEPTH, N_EXPERTS, D, 2 * D_EXPERT), D ** -0.5),
        'expert_b1': nrm((DEPTH, N_EXPERTS, 2 * D_EXPERT), 0.02),
        'expert_w2': nrm((DEPTH, N_EXPERTS, D_EXPERT, D), D_EXPERT ** -0.5),
        'expert_b2': nrm((DEPTH, N_EXPERTS, D), 0.02),
    }


def reference(x, c, ctx, c_ctx, ada_w, ada_b, norm_mix_pre, norm_mix_post, norm_ffn_pre, norm_ffn_post,
              w_in, w_branch_gate, b_branch_gate, w_branch, w_out, pool_w, pool_scale,
              ssm_a_re, ssm_a_im, ssm_log_dt, ssm_b_re, ssm_b_im, ssm_c_re, ssm_c_im, ssm_d, ssm_w_glu,
              gmlp_ln_g, gmlp_ln_b, gmlp_w_s, gmlp_b_s, na_rpb,
              router_w, router_b, expert_w1, expert_b1, expert_w2, expert_b2):
    B_, L_, D = x.shape
    Lc = ctx.shape[1]
    xl, xc = x, ctx
    silu_c = jax.nn.silu(c)
    silu_cc = jax.nn.silu(c_ctx)
    for l in range(DEPTH):
        last = l == DEPTH - 1
        mod_l = (silu_c @ ada_w[l] + ada_b[l])[:, None, :]
        mod_c = (silu_cc @ ada_w[l] + ada_b[l])[None, None, :]
        sh_m_l, sc_m_l, g_m_l, sh_f_l, sc_f_l, g_f_l = jnp.split(mod_l, 6, axis=-1)
        sh_m_c, sc_m_c, g_m_c, sh_f_c, sc_f_c, g_f_c = jnp.split(mod_c, 6, axis=-1)

        hl = modulate(rmsnorm(xl, norm_mix_pre[l]), sh_m_l, sc_m_l)
        hc = modulate(rmsnorm(xc, norm_mix_pre[l]), sh_m_c, sc_m_c)
        yl, yc = token_mixers(hl, hc, w_in[l], w_branch_gate[l], b_branch_gate[l], w_branch[l], w_out[l],
                              pool_w[l], pool_scale[l],
                              ssm_a_re[l], ssm_a_im[l], ssm_log_dt[l], ssm_b_re[l], ssm_b_im[l],
                              ssm_c_re[l], ssm_c_im[l], ssm_d[l], ssm_w_glu[l],
                              gmlp_ln_g[l], gmlp_ln_b[l], gmlp_w_s[l], gmlp_b_s[l], na_rpb[l],
                              not last)
        xl = xl + g_m_l * rmsnorm(yl, norm_mix_post[l])
        if not last:
            xc = xc + g_m_c * rmsnorm(yc, norm_mix_post[l])

        hl = modulate(rmsnorm(xl, norm_ffn_pre[l]), sh_f_l, sc_f_l)
        if last:
            yl = moe(hl.reshape(B_ * L_, D), router_w[l], router_b[l], expert_w1[l], expert_b1[l],
                     expert_w2[l], expert_b2[l]).reshape(B_, L_, D)
        else:
            hc = modulate(rmsnorm(xc, norm_ffn_pre[l]), sh_f_c, sc_f_c)
            tok = jnp.concatenate([hl.reshape(B_ * L_, D), hc.reshape(B_ * Lc, D)], axis=0)
            y = moe(tok, router_w[l], router_b[l], expert_w1[l], expert_b1[l], expert_w2[l], expert_b2[l])
            yl = y[:B_ * L_].reshape(B_, L_, D)
            yc = y[B_ * L_:].reshape(B_, Lc, D)
            xc = xc + g_f_c * rmsnorm(yc, norm_ffn_post[l])
        xl = xl + g_f_l * rmsnorm(yl, norm_ffn_post[l])
    return xl
```

```cpp
#include <hip/hip_runtime.h>
#include <cstdio>
#include <cstdint>


#ifndef N_LAUNCH_MODE
#define N_LAUNCH_MODE 1
#endif
#ifndef USE_ENGINE
#define USE_ENGINE 1
#endif


#ifndef REP_PREP
#define REP_PREP 1
#endif
#ifndef REP_GLN
#define REP_GLN 1
#endif
#ifndef REP_POOL
#define REP_POOL 1
#endif
#ifndef REP_ATT
#define REP_ATT 1
#endif
#ifndef REP_MIX
#define REP_MIX 1
#endif
#ifndef REP_G1
#define REP_G1 1
#endif
#ifndef REP_MOE
#define REP_MOE 1
#endif
#ifndef REP_G2
#define REP_G2 1
#endif
#ifndef REP_G3
#define REP_G3 1
#endif
#ifndef REP_S5
#define REP_S5 1
#endif
#ifndef DBG_MOE
#define DBG_MOE 0
#endif
#ifndef DBG_G3
#define DBG_G3 0
#endif
typedef unsigned short bf16;
typedef float f32x4 __attribute__((ext_vector_type(4)));
typedef float f32x2 __attribute__((ext_vector_type(2)));
typedef short bf16x8 __attribute__((ext_vector_type(8)));
typedef unsigned u32x4 __attribute__((ext_vector_type(4)));
typedef unsigned u32x2 __attribute__((ext_vector_type(2)));
#define LAS __attribute__((address_space(3)))

constexpr int D = 1024, NBATCH = 4, SEQ = 4096, CTXL = 256, DEPTH = 2;
constexpr int NLAT = NBATCH * SEQ, NCTX = NBATCH * CTXL, MT = NLAT + NCTX;
constexpr int INW = 1792, NG1 = INW + 4096;
constexpr int NEXP = 32, DEXP = 1024;
constexpr int NCHUNK = MT / 16, NCHUNK_PAD = 1280;
constexpr int XB_ROWS = 78080;
constexpr float EPS = 1e-6f;
constexpr float F8_W = 64.f, F8_X = 8.f, F8_ACT = 4.f, F8_Y = 8.f, F8_B = 8.f, F8_G = 255.f;
constexpr int MOE_CAP = 17408;
constexpr int F8_SC_W = 0x79797979, F8_SC_X = 0x7c7c7c7c, F8_SC_ACT = 0x7d7d7d7d;

constexpr size_t al256(size_t x) { return (x + 255) & ~(size_t)255; }
constexpr size_t WS_CTL = 0, CTL_BYTES = 1u << 20;
constexpr size_t WS_MODS = WS_CTL + CTL_BYTES;
constexpr size_t WS_ROPE = WS_MODS + al256((size_t)DEPTH * 5 * 6144 * 4);
constexpr size_t WS_A16 = WS_ROPE + al256(65 * 16 * 2 * 4);
constexpr size_t WS_WINT = WS_A16 + al256((size_t)DEPTH * 2 * 16 * 64 * 2 * 4);
constexpr size_t WS_WBRT = WS_WINT + al256((size_t)DEPTH * NG1 * D * 2);
constexpr size_t WS_WOUTT = WS_WBRT + al256((size_t)DEPTH * 4 * D * 256 * 2);
constexpr size_t WS_WGLUT = WS_WOUTT + al256((size_t)DEPTH * D * D * 2);
constexpr size_t WS_WST = WS_WGLUT + al256((size_t)DEPTH * 512 * 256 * 2);
constexpr size_t WS_BT1 = WS_WST + al256((size_t)DEPTH * 4 * 256 * 128 * 2);
constexpr size_t WS_BT3 = WS_BT1 + al256((size_t)DEPTH * 16 * 256 * 256 * 2);
constexpr size_t WS_W1T = WS_BT3 + al256((size_t)DEPTH * 16 * 256 * 512 * 2);
constexpr size_t WS_W2T = WS_W1T + al256((size_t)DEPTH * NEXP * 2048 * D);
constexpr size_t WS_XS = WS_W2T + al256((size_t)DEPTH * NEXP * D * D);
constexpr size_t WS_H = WS_XS + al256((size_t)MT * D * 4);
constexpr size_t WS_P = WS_H + al256((size_t)MT * D * 2);
constexpr size_t WS_GATES = WS_P + al256((size_t)MT * INW * 2);
constexpr size_t WS_ACAT = WS_GATES + al256((size_t)MT * 4096 * 2);
constexpr size_t WS_SST = WS_ACAT + al256((size_t)NCHUNK_PAD * 16 * 512 * 2);
constexpr size_t WS_VT = WS_SST + al256((size_t)NCHUNK_PAD * 16 * 256 * 4);
constexpr size_t WS_YG = WS_VT + al256((size_t)4 * 8704 * 128 * 2);
constexpr size_t WS_BR = WS_YG + al256((size_t)MT * 256 * 2);
constexpr size_t WS_MRGF = WS_BR + al256((size_t)MT * D * 2);
constexpr size_t WS_MRG = WS_MRGF + 256;
constexpr size_t WS_Y = WS_MRG + al256((size_t)MT * D * 2);
constexpr size_t WS_RE = WS_Y + al256((size_t)MT * D * 4);
constexpr size_t WS_RS = WS_RE + al256((size_t)MT * 16);
constexpr size_t WS_RW = WS_RS + al256((size_t)MT * 16);
constexpr size_t WS_TILE = WS_RW + al256((size_t)MT * 16);
constexpr size_t WS_XB = WS_TILE + 4096;
constexpr size_t WS_ACT = WS_XB + al256((size_t)NEXP * MOE_CAP * D);
constexpr size_t WS_YB = WS_ACT + al256((size_t)XB_ROWS * D);
constexpr size_t WS_VT2 = WS_YB + al256((size_t)XB_ROWS * D * 2);
constexpr size_t WS_RWF = WS_VT2 + al256((size_t)256 * MT * 2);
constexpr size_t WS_WBG8 = WS_RWF + al256((size_t)DEPTH * 32 * 2 * 2 * 64 * 16);
constexpr size_t WS_H8 = WS_WBG8 + al256((size_t)DEPTH * 4096 * D);
constexpr size_t WS_BR8 = WS_H8 + al256((size_t)MT * D);
constexpr size_t WS_END = WS_BR8 + al256((size_t)MT * D);
constexpr int CW_BAR = 4096;
constexpr int CW_CNT = 16384;

constexpr int LDS_STAGE = 131072, LDS_MISC = 133120, LDS_BYTES = 147456;

__device__ __forceinline__ float bf2f(unsigned v) { return __uint_as_float(v << 16); }
__device__ __forceinline__ unsigned f2bf(float f) { unsigned u = __float_as_uint(f); return (u + 0x7fffu + ((u >> 16) & 1u)) >> 16; }
__device__ __forceinline__ unsigned pk2(float lo, float hi) { unsigned r; asm volatile("v_cvt_pk_bf16_f32 %0, %1, %2" : "=v"(r) : "v"(lo), "v"(hi)); return r; }
#define SWZ_XOR(v, o) __builtin_bit_cast(float, __builtin_amdgcn_ds_swizzle(__builtin_bit_cast(int, (v)), ((o) << 10) | 0x1f))
#define SWZ_XOR_I(v, o) __builtin_amdgcn_ds_swizzle((v), ((o) << 10) | 0x1f)
__device__ __forceinline__ float wave_sum(float v) {
    v += SWZ_XOR(v, 1); v += SWZ_XOR(v, 2); v += SWZ_XOR(v, 4); v += SWZ_XOR(v, 8); v += SWZ_XOR(v, 16);
    return __builtin_bit_cast(float, __builtin_amdgcn_readlane(__builtin_bit_cast(int, v), 0)) + __builtin_bit_cast(float, __builtin_amdgcn_readlane(__builtin_bit_cast(int, v), 32));
}
__device__ __forceinline__ unsigned pk4_fp8(float a, float b, float c, float d) {
    a = fminf(fmaxf(a, -448.f), 448.f); b = fminf(fmaxf(b, -448.f), 448.f); c = fminf(fmaxf(c, -448.f), 448.f); d = fminf(fmaxf(d, -448.f), 448.f);
    int p = __builtin_amdgcn_cvt_pk_fp8_f32(a, b, 0, false); p = __builtin_amdgcn_cvt_pk_fp8_f32(c, d, p, true); return (unsigned)p;
}
__device__ __forceinline__ unsigned pk4_fp8_nc(float a, float b, float c, float d) {
    int p = __builtin_amdgcn_cvt_pk_fp8_f32(a, b, 0, false); p = __builtin_amdgcn_cvt_pk_fp8_f32(c, d, p, true); return (unsigned)p;
}
__device__ __forceinline__ unsigned pk4_u8(float a, float b, float c, float d) {
    unsigned r = __builtin_amdgcn_cvt_pk_u8_f32(a, 0, 0u); r = __builtin_amdgcn_cvt_pk_u8_f32(b, 1, r); r = __builtin_amdgcn_cvt_pk_u8_f32(c, 2, r); return __builtin_amdgcn_cvt_pk_u8_f32(d, 3, r);
}
__device__ __forceinline__ unsigned char f8_1(float v) { v = fminf(fmaxf(v, -448.f), 448.f); return (unsigned char)(__builtin_amdgcn_cvt_pk_fp8_f32(v, v, 0, false) & 0xff); }
__device__ __forceinline__ float wave_max(float v) {
    v = fmaxf(v, SWZ_XOR(v, 1)); v = fmaxf(v, SWZ_XOR(v, 2)); v = fmaxf(v, SWZ_XOR(v, 4)); v = fmaxf(v, SWZ_XOR(v, 8)); v = fmaxf(v, SWZ_XOR(v, 16));
    return fmaxf(__builtin_bit_cast(float, __builtin_amdgcn_readlane(__builtin_bit_cast(int, v), 0)), __builtin_bit_cast(float, __builtin_amdgcn_readlane(__builtin_bit_cast(int, v), 32)));
}
__device__ __forceinline__ float sigmoidf_(float x) { return __builtin_amdgcn_rcpf(1.f + __expf(-x)); }
__device__ __forceinline__ float sigmoid_g(float x) { return __builtin_amdgcn_rcpf(__builtin_fmaf(__builtin_amdgcn_exp2f(x * -1.4426950408889634f), 1.f / F8_G, 1.f / F8_G)); }
__device__ __forceinline__ float gelu_tanh(float x) {
    const float w = x * (-2.f * 0.7978845608028654f * 1.4426950408889634f - (2.f * 0.7978845608028654f * 0.044715f * 1.4426950408889634f) * (x * x));
    return x * __builtin_amdgcn_rcpf(1.f + __builtin_amdgcn_exp2f(w));
}

#define XB_TMO      128
#define XB_XCNT(j)  (256  + 64 * (j))
#define XB_XSUB(j)  (1280 + 64 * (j))
#define XB_XGEN(j)  (2304 + 64 * (j))
#define XB_TOP      3328
#define XB_TOPGEN   3392
#define XCD_BAR_WORDS 3456
#define XB_SPIN_CAP (1u << 22)
__device__ __forceinline__ unsigned xb_ld(unsigned* p)              { return __hip_atomic_load(p, __ATOMIC_RELAXED, __HIP_MEMORY_SCOPE_AGENT); }
__device__ __forceinline__ unsigned xb_add(unsigned* p, unsigned v) { return __hip_atomic_fetch_add(p, v, __ATOMIC_RELAXED, __HIP_MEMORY_SCOPE_AGENT); }
__device__ __forceinline__ unsigned xb_xcc_id() { return (unsigned)__builtin_amdgcn_s_getreg((3 << 11) | 20) & 0xFu; }
#define XB_SPIN(cond, bar) do { unsigned _sp = 0; while (cond) { __builtin_amdgcn_s_sleep(1); \
    if ((++_sp & 255u) == 0u) { if (xb_ld(&(bar)[XB_TMO])) break; if (_sp > XB_SPIN_CAP) { atomicAdd(&(bar)[XB_TMO], 1u); break; } } } } while (0)
struct XcdBarrier { unsigned* bar; unsigned x; volatile LAS unsigned* st; };
__device__ __forceinline__ XcdBarrier xcd_barrier_post(unsigned* bar, volatile LAS unsigned* st) {
    XcdBarrier b; b.bar = bar; b.x = xb_xcc_id(); b.st = st;
    if (threadIdx.x == 0) (void)xb_add(&bar[XB_XCNT(b.x)], 1u);
    return b;
}
__device__ __forceinline__ void xcd_barrier_complete(unsigned* bar, unsigned x, unsigned& nloc, unsigned& nx) {
    const unsigned G = gridDim.x * gridDim.y * gridDim.z;
    unsigned sum, cnt, mine, sp = 0u;
    for (;;) {
        sum = 0u; cnt = 0u; mine = 0u;
#pragma unroll
        for (unsigned j = 0; j < 16; ++j) { const unsigned c = xb_ld(&bar[XB_XCNT(j)]); sum += c; cnt += (c > 0u) ? 1u : 0u; mine = (j == x) ? c : mine; }
        if (sum == G) break;
        __builtin_amdgcn_s_sleep(1);
        if ((++sp & 255u) == 0u) { if (xb_ld(&bar[XB_TMO])) break; if (sp > XB_SPIN_CAP) { atomicAdd(&bar[XB_TMO], 1u); break; } }
    }
    nloc = mine > 0u ? mine : 1u; nx = cnt > 0u ? cnt : 1u;
}
__device__ __forceinline__ void xcd_barrier(const XcdBarrier& b) {
    asm volatile("s_waitcnt vmcnt(0)" ::: "memory");
    __syncthreads();
    if (threadIdx.x == 0) {
        unsigned* bar = b.bar;
        __builtin_amdgcn_s_waitcnt(0);
        unsigned nloc = b.st[0], nx = b.st[1];
        if (nloc == 0u) { xcd_barrier_complete(bar, b.x, nloc, nx); b.st[0] = nloc; b.st[1] = nx; }
        const unsigned old = xb_add(&bar[XB_XSUB(b.x)], 1u);
        const unsigned gen = old / nloc;
        if (old + 1u == (gen + 1u) * nloc) {
            __builtin_amdgcn_fence(__ATOMIC_RELEASE, "agent");
            asm volatile("s_waitcnt vmcnt(0)" ::: "memory");
            const unsigned og = xb_add(&bar[XB_TOP], 1u);
            const unsigned tg = og / nx;
            if (og + 1u == (tg + 1u) * nx) xb_add(&bar[XB_TOPGEN], 1u);
            else XB_SPIN(xb_ld(&bar[XB_TOPGEN]) == tg, bar);
            __builtin_amdgcn_fence(__ATOMIC_ACQUIRE, "agent");
            xb_add(&bar[XB_XGEN(b.x)], 1u);
            asm volatile("s_waitcnt vmcnt(0)" ::: "memory");
        } else {
            XB_SPIN(xb_ld(&bar[XB_XGEN(b.x)]) == gen, bar);
            __builtin_amdgcn_fence(__ATOMIC_ACQUIRE, "agent");
            asm volatile("s_waitcnt vmcnt(0)" ::: "memory");
        }
    }
    __syncthreads();
}

__device__ __forceinline__ const char* uptr(const char* p) {
    const unsigned long long v = (unsigned long long)p;
    const unsigned lo = __builtin_amdgcn_readfirstlane((unsigned)v), hi = __builtin_amdgcn_readfirstlane((unsigned)(v >> 32));
    return (const char*)(((unsigned long long)hi << 32) | lo);
}
namespace pg8 {
constexpr int BM = 256, BK = 64, HALF = 128, HTB = HALF * BK * 2, STAGE_BYTES = 8 * HTB, NXCD = 8, WGM = 8;
__host__ __device__ __forceinline__ int lds_byte(int r, int c) { const int st = (r >> 4) * 2 + (c >> 5), rr = r & 15, cc = c & 31, ob = rr * 64 + cc * 2; return st * 1024 + (ob ^ (((ob >> 9) & 1) << 5)); }
__host__ __device__ __forceinline__ void stage_rc(int b, int& R, int& C) { const int st = b / 1024, sb = b % 1024, swz = sb ^ (((sb >> 9) & 1) << 5); R = (st >> 1) * 16 + swz / 64; C = (st & 1) * 32 + (swz % 64) / 2; }

struct Unit { int pm, pn, aux; const char* a; const char* b; };
struct Gemm { int lda, ldb, K; int sc_w = 0x7f7f7f7f, sc_x = 0x7f7f7f7f; };

__device__ __forceinline__ bool plain_order(int L, int nM, int nN, int& pm, int& pn) {
    const int nwg = nM * nN; if (L >= nwg) return false;
    int wgid = L; { const int q = nwg / NXCD, r = nwg % NXCD, xcd = wgid % NXCD, off = wgid / NXCD; wgid = (xcd < r ? xcd * (q + 1) : r * (q + 1) + (xcd - r) * q) + off; }
    const int nig = WGM * nN, gid = wgid / nig, fm = gid * WGM, gsz = (nM - fm) < WGM ? (nM - fm) : WGM;
    pm = fm + ((wgid % nig) % gsz); pn = (wgid % nig) / gsz; return true;
}

typedef int v8i32 __attribute__((ext_vector_type(8)));
__device__ __forceinline__ v8i32 cat8(bf16x8 lo, bf16x8 hi) { const u32x4 a = __builtin_bit_cast(u32x4, lo), b = __builtin_bit_cast(u32x4, hi);
    return (v8i32){(int)a.x, (int)a.y, (int)a.z, (int)a.w, (int)b.x, (int)b.y, (int)b.z, (int)b.w}; }
template <class Epi, class Sched, bool FP8 = false, int DBG = 0>
__device__ __forceinline__ void gemm_phase(LAS unsigned char* lds, const Gemm g, const Sched& S, const Epi& E) {
    int tid_ = threadIdx.x; asm volatile("" : "+v"(tid_));
    const int tid = tid_, wid = __builtin_amdgcn_readfirstlane(tid >> 6), lane = tid & 63, wr = wid >> 2, wc = wid & 3, fr = lane & 15, fq = lane >> 4;
    const int K = g.K, nt = K / BK;
    unsigned voffA[2], voffB[2];
#pragma unroll
    for (int i = 0; i < 2; ++i) { int R, C; stage_rc(tid * 16 + i * 8192, R, C);
        voffA[i] = (unsigned)(R * g.lda + C) * 2u; voffB[i] = (unsigned)(R * g.ldb + C) * 2u; }
    const size_t kstep = (size_t)(BK * 2);
    const size_t hstepA = (size_t)HALF * g.lda * 2, hstepB = (size_t)HALF * g.ldb * 2;
    const unsigned ldsw = (unsigned)wid * 1024u;
    const int aoff = lds_byte(wr * 64 + fr, fq * 8), boff = lds_byte(wc * 32 + fr, fq * 8);
#define PG8_SA(b, h) (((b) * 2 + (h)) * HTB)
#define PG8_SB(b, h) ((4 + (b) * 2 + (h)) * HTB)
#define PG8_STAGE(bufoff, gbase, voff) do { if constexpr (!(DBG & 4)) { _Pragma("unroll") for (int _i = 0; _i < 2; ++_i) \
        __builtin_amdgcn_global_load_lds((const unsigned*)((const char*)(gbase) + (voff)[_i]), (LAS unsigned*)(lds + (bufoff) + ldsw + _i * 8192), 16, 0, 0); } } while (0)
#define PG8_LD8(p_) ({ const u32x4 lo_ = *(const LAS u32x4*)(p_), hi_ = *(const LAS u32x4*)((p_) + 1024); (v8i32){(int)lo_.x, (int)lo_.y, (int)lo_.z, (int)lo_.w, (int)hi_.x, (int)hi_.y, (int)hi_.z, (int)hi_.w}; })
#define PG8_LDA(dst, b, h) do { if constexpr (!(DBG & 8)) { _Pragma("unroll") for (int m = 0; m < 4; ++m) dst[m] = PG8_LD8(lds + PG8_SA(b, h) + aoff + m * 2048); } } while (0)
#define PG8_LDB(dst, b, h) do { if constexpr (!(DBG & 8)) { _Pragma("unroll") for (int n = 0; n < 2; ++n) dst[n] = PG8_LD8(lds + PG8_SB(b, h) + boff + n * 2048); } } while (0)
#define PG8_LO(v_) __builtin_bit_cast(bf16x8, __builtin_shufflevector(v_, v_, 0, 1, 2, 3))
#define PG8_HI(v_) __builtin_bit_cast(bf16x8, __builtin_shufflevector(v_, v_, 4, 5, 6, 7))
#define PG8_MMA(ai, bj, At, Bt) do { __builtin_amdgcn_s_setprio(1); _Pragma("unroll") for (int m = 0; m < 4; ++m) _Pragma("unroll") for (int n = 0; n < 2; ++n) { \
        if constexpr (DBG & 2) asm volatile("" :: "v"(Bt[n]), "v"(At[m])); \
        else if constexpr (FP8) asm volatile("s_nop 1\n\tv_mfma_f32_16x16x128_f8f6f4 %0, %1, %2, %0" : "+v"(acc[ai][bj][m][n]) : "v"(Bt[n]), "v"(At[m]));   \
        else { acc[ai][bj][m][n] = __builtin_amdgcn_mfma_f32_16x16x32_bf16(PG8_LO(Bt[n]), PG8_LO(At[m]), acc[ai][bj][m][n], 0, 0, 0); \
               acc[ai][bj][m][n] = __builtin_amdgcn_mfma_f32_16x16x32_bf16(PG8_HI(Bt[n]), PG8_HI(At[m]), acc[ai][bj][m][n], 0, 0, 0); } } \
        __builtin_amdgcn_s_setprio(0); } while (0)
#define PG8_WAIT_V(n) asm volatile("s_waitcnt vmcnt(" #n ")" ::: "memory")
#define PG8_WAIT_L(n) asm volatile("s_waitcnt lgkmcnt(" #n ")" ::: "memory")
#define PG8_BAR __builtin_amdgcn_s_barrier()
#define PG8_SCHED __builtin_amdgcn_sched_barrier(0)
    Unit cur, nxt; int ui = 0;
    if (!S.next(0, cur)) return;
    f32x4 acc[2][2][4][2];
#pragma unroll
    for (int a = 0; a < 2; ++a)
#pragma unroll
        for (int b = 0; b < 2; ++b)
#pragma unroll
            for (int m = 0; m < 4; ++m)
#pragma unroll
                for (int n = 0; n < 2; ++n) acc[a][b][m][n] = (f32x4){0.f, 0.f, 0.f, 0.f};
    v8i32 At[4] = {}, B0[2] = {}, B1[2] = {};
    const int sc_w_ = g.sc_w, sc_x_ = g.sc_x;
    const char* cA = uptr(cur.a); const char* cB = uptr(cur.b);
    PG8_STAGE(PG8_SB(0, 0), cB, voffB); PG8_STAGE(PG8_SB(0, 1), cB + hstepB, voffB); PG8_STAGE(PG8_SA(0, 0), cA, voffA); PG8_STAGE(PG8_SA(0, 1), cA + hstepA, voffA);
    if (wr == 1) PG8_BAR;
    PG8_WAIT_V(2); PG8_BAR;
    PG8_STAGE(PG8_SB(1, 0), cB + kstep, voffB); PG8_STAGE(PG8_SA(1, 0), cA + kstep, voffA); PG8_STAGE(PG8_SB(1, 1), cB + hstepB + kstep, voffB);
    PG8_WAIT_V(6); PG8_BAR;
    for (;;) {
        const bool has_next = S.next(ui + 1, nxt);
        const char* nA = has_next ? uptr(nxt.a) : cA; const char* nB = has_next ? uptr(nxt.b) : cB;
        for (int t = 0; t < nt; t += 2) {
            const bool last = (t == nt - 2);
            const char* a1 = cA + (size_t)(t + 1) * kstep;
            const char* a2 = last ? nA : cA + (size_t)(t + 2) * kstep; const char* b2 = last ? nB : cB + (size_t)(t + 2) * kstep;
            const char* a3 = a2 + kstep; const char* b3 = b2 + kstep;
            asm volatile("" : "+s"(a1), "+s"(a2), "+s"(a3), "+s"(b2), "+s"(b3));
            PG8_LDB(B0, 0, 0); PG8_LDB(B1, 0, 1); PG8_SCHED; PG8_LDA(At, 0, 0); PG8_STAGE(PG8_SA(1, 1), a1 + hstepA, voffA);
            PG8_WAIT_V(8); PG8_WAIT_L(0); PG8_BAR; PG8_MMA(0, 0, At, B0); PG8_MMA(0, 1, At, B1); PG8_BAR; PG8_SCHED;
            PG8_LDA(At, 0, 1); PG8_STAGE(PG8_SB(0, 0), b2, voffB); PG8_STAGE(PG8_SB(0, 1), b2 + hstepB, voffB); PG8_STAGE(PG8_SA(0, 0), a2, voffA);
            PG8_WAIT_V(8); PG8_WAIT_L(0); PG8_BAR; PG8_MMA(1, 0, At, B0); PG8_MMA(1, 1, At, B1); PG8_BAR; PG8_SCHED;
            PG8_LDB(B0, 1, 0); PG8_LDB(B1, 1, 1); PG8_SCHED; PG8_LDA(At, 1, 0); PG8_STAGE(PG8_SA(0, 1), a2 + hstepA, voffA);
            PG8_WAIT_V(8); PG8_WAIT_L(0); PG8_BAR; PG8_MMA(0, 0, At, B0); PG8_MMA(0, 1, At, B1); PG8_BAR; PG8_SCHED;
            PG8_LDA(At, 1, 1); PG8_STAGE(PG8_SB(1, 0), b3, voffB); PG8_STAGE(PG8_SB(1, 1), b3 + hstepB, voffB); PG8_STAGE(PG8_SA(1, 0), a3, voffA);
            PG8_WAIT_V(8); PG8_WAIT_L(0); PG8_BAR; PG8_MMA(1, 0, At, B0); PG8_MMA(1, 1, At, B1); PG8_BAR; PG8_SCHED;
        }
        if constexpr (FP8) { asm volatile("s_nop 15\n\ts_nop 15" ::: "memory");
            _Pragma("unroll") for (int a = 0; a < 2; ++a) _Pragma("unroll") for (int b = 0; b < 2; ++b) _Pragma("unroll") for (int m = 0; m < 4; ++m) _Pragma("unroll") for (int n = 0; n < 2; ++n)
                asm volatile("" : "+v"(acc[a][b][m][n])); }
        if (wr == 0) PG8_BAR;
        { int efr = fr, efq = fq; asm volatile("" : "+v"(efr), "+v"(efq));
          if constexpr (!(DBG & 1)) E(acc, cur, wr, wc, efr, efq);
          else { _Pragma("unroll") for (int a = 0; a < 2; ++a) _Pragma("unroll") for (int b = 0; b < 2; ++b) _Pragma("unroll") for (int m = 0; m < 4; ++m) _Pragma("unroll") for (int n = 0; n < 2; ++n) asm volatile("" :: "v"(acc[a][b][m][n])); } }
        if (!has_next) break;
#pragma unroll
        for (int a = 0; a < 2; ++a)
#pragma unroll
            for (int b = 0; b < 2; ++b)
#pragma unroll
                for (int m = 0; m < 4; ++m)
#pragma unroll
                    for (int n = 0; n < 2; ++n) acc[a][b][m][n] = (f32x4){0.f, 0.f, 0.f, 0.f};
        cur = nxt; cA = nA; cB = nB; ++ui;
        if (wr == 1) PG8_BAR;
    }
    PG8_WAIT_V(0);
    PG8_BAR;
#undef PG8_SA
#undef PG8_SB
#undef PG8_STAGE
#undef PG8_LDA
#undef PG8_LDB
#undef PG8_LD8
#undef PG8_LO
#undef PG8_HI
#undef PG8_MMA
#undef PG8_WAIT_V
#undef PG8_WAIT_L
#undef PG8_BAR
#undef PG8_SCHED
}

template <class Epi, class Sched>
__device__ __forceinline__ void gemm_naive(float* slab_all, const Gemm g, const Sched& S, const Epi& E) {
    int tid_ = threadIdx.x; asm volatile("" : "+v"(tid_));
    const int tid = tid_, wid = __builtin_amdgcn_readfirstlane(tid >> 6), lane = tid & 63, wr = wid >> 2, wc = wid & 3, fr = lane & 15, fq = lane >> 4;
    float* slab = slab_all + (size_t)blockIdx.x * 65536;
    Unit u;
    for (int ui = 0; S.next(ui, u); ++ui) {
#pragma unroll 1
        for (int idx = 0; idx < 32; ++idx) {
            const int ai = idx >> 4, m = (idx >> 2) & 3, bj = (idx >> 1) & 1, n = idx & 1;
            const char* ap = u.a + (size_t)(ai * 128 + wr * 64 + m * 16 + fr) * g.lda * 2;
            const char* bp = u.b + (size_t)(bj * 128 + wc * 32 + n * 16 + fq * 4) * g.ldb * 2;
            f32x4 s = (f32x4){0.f, 0.f, 0.f, 0.f};
#pragma unroll 1
            for (int k0 = 0; k0 < g.K; k0 += 8) {
                const u32x4 va = *(const u32x4*)(ap + k0 * 2);
#pragma unroll
                for (int j = 0; j < 4; ++j) { const u32x4 vb = *(const u32x4*)(bp + ((size_t)j * g.ldb + k0) * 2);
#pragma unroll
                    for (int q = 0; q < 4; ++q) s[j] += bf2f(va[q] & 0xffffu) * bf2f(vb[q] & 0xffffu) + bf2f(va[q] >> 16) * bf2f(vb[q] >> 16); }
            }
            *(f32x4*)(slab + ((size_t)tid * 32 + idx) * 4) = s;
        }
        f32x4 acc[2][2][4][2];
#pragma unroll
        for (int ai = 0; ai < 2; ++ai)
#pragma unroll
            for (int m = 0; m < 4; ++m)
#pragma unroll
                for (int bj = 0; bj < 2; ++bj)
#pragma unroll
                    for (int n = 0; n < 2; ++n) acc[ai][bj][m][n] = *(const f32x4*)(slab + (size_t)tid * 128 + (ai * 16 + m * 4 + bj * 2 + n) * 4);
        { int efr = fr, efq = fq; asm volatile("" : "+v"(efr), "+v"(efq)); E(acc, u, wr, wc, efr, efq); }
    }
}
}

template <class Epi, class Sched, bool FP8 = false, int DBG = 0>
__device__ __forceinline__ void run_gemm(LAS unsigned char* lds, unsigned char* g_slab, const pg8::Gemm g, const Sched& S, const Epi& E) {
#if USE_ENGINE
    pg8::gemm_phase<Epi, Sched, FP8, DBG>(lds, g, S, E);
#else
    pg8::gemm_naive<Epi, Sched>((float*)(g_slab), g, S, E);
#endif
}

struct Args { const float* in[37]; float* out; unsigned char* ws; int ph_lo, ph_hi; };
enum { I_X = 0, I_C, I_CTX, I_CCTX, I_ADAW, I_ADAB, I_NMPRE, I_NMPOST, I_NFPRE, I_NFPOST, I_WIN, I_WBG, I_BBG, I_WBR, I_WOUT, I_POOLW, I_POOLS,
       I_SARE, I_SAIM, I_SLDT, I_SBRE, I_SBIM, I_SCRE, I_SCIM, I_SD, I_SWGLU, I_LNG, I_LNB, I_GWS, I_GBS, I_RPB, I_RW, I_RB, I_W1, I_B1, I_W2, I_B2 };

struct Ctx {
    const Args* a; unsigned char* ws; LAS unsigned char* lds;
    int tid, lane, wid, G, bid, gw, NGW, brot;
};
#define LAUNDER(cin) Ctx c = cin; c.tid = threadIdx.x; asm volatile("" : "+v"(c.tid)); c.lane = c.tid & 63; c.wid = __builtin_amdgcn_readfirstlane(c.tid >> 6); c.bid = blockIdx.x; if (c.brot) c.bid = (c.bid + c.G - c.brot) % c.G; asm volatile("" : "+s"(c.bid)); c.gw = c.bid * 8 + c.wid
__device__ __forceinline__ const float* xin_row(const Args& a, int row) { return row < NLAT ? a.in[I_X] + (size_t)row * D : a.in[I_CTX] + (size_t)(row - NLAT) * D; }
__device__ __forceinline__ const float* mod_ptr(unsigned char* ws, int l, int row, int which) {
    const int r5 = row < NLAT ? row / SEQ : 4;
    return (const float*)(ws + WS_MODS) + ((size_t)(l * 5 + r5) * 6 + which) * 1024;
}

__device__ __forceinline__ int rowmap(int n, int kind, int NH) {
    if (kind == 0) return n;
    const int half = n >= NH ? 1 : 0, j = n - half * NH; return 256 * (j >> 7) + 128 * half + (j & 127);
}
__device__ __forceinline__ void transpose_item(const float* W, int K, int N, bf16* WT, int ldd, int row_off, int kind, LAS float* scr, int item, int lane) {
    const int nblk = N / 64, kb = item / nblk, nb = item % nblk, k0 = 64 * kb, n0 = 64 * nb;
    f32x4 v[16];
#pragma unroll
    for (int i = 0; i < 16; ++i) v[i] = *(const f32x4*)(W + (size_t)(k0 + 4 * i + (lane >> 4)) * N + n0 + 4 * (lane & 15));
#pragma unroll
    for (int i = 0; i < 16; ++i) { LAS float* d = scr + (4 * i + (lane >> 4)) * 65 + 4 * (lane & 15); d[0] = v[i].x; d[1] = v[i].y; d[2] = v[i].z; d[3] = v[i].w; }
    asm volatile("s_waitcnt lgkmcnt(0)" ::: "memory");
    const int c = lane & 7;
#pragma unroll
    for (int j = 0; j < 8; ++j) { const int n = (lane >> 3) + 8 * j; const LAS float* sp = scr + (8 * c) * 65 + n;
        u32x4 o; o.x = pk2(sp[0 * 65], sp[1 * 65]); o.y = pk2(sp[2 * 65], sp[3 * 65]); o.z = pk2(sp[4 * 65], sp[5 * 65]); o.w = pk2(sp[6 * 65], sp[7 * 65]);
        *(u32x4*)(WT + (size_t)(row_off + rowmap(n0 + n, kind, N / 2)) * ldd + k0 + 8 * c) = o; }
    asm volatile("s_waitcnt lgkmcnt(0)" ::: "memory");
}
__device__ __forceinline__ void tr_store_f8(const float* dummy, bf16* WT8, int k0, int n0, int N, int ldd_bytes, int kind, LAS float* scr, int lane, const f32x4 (&v)[16]) {
#pragma unroll
    for (int i = 0; i < 16; ++i) { LAS float* d = scr + (4 * i + (lane >> 4)) * 65 + 4 * (lane & 15); d[0] = v[i].x; d[1] = v[i].y; d[2] = v[i].z; d[3] = v[i].w; }
    asm volatile("s_waitcnt lgkmcnt(0)" ::: "memory");
    const int c = lane & 3; unsigned char* base = (unsigned char*)WT8;
#pragma unroll
    for (int j = 0; j < 4; ++j) { const int n = (lane >> 2) + 16 * j; const LAS float* sp = scr + (16 * c) * 65 + n;
        u32x4 o; o.x = pk4_fp8(sp[0 * 65] * F8_W, sp[1 * 65] * F8_W, sp[2 * 65] * F8_W, sp[3 * 65] * F8_W); o.y = pk4_fp8(sp[4 * 65] * F8_W, sp[5 * 65] * F8_W, sp[6 * 65] * F8_W, sp[7 * 65] * F8_W);
        o.z = pk4_fp8(sp[8 * 65] * F8_W, sp[9 * 65] * F8_W, sp[10 * 65] * F8_W, sp[11 * 65] * F8_W); o.w = pk4_fp8(sp[12 * 65] * F8_W, sp[13 * 65] * F8_W, sp[14 * 65] * F8_W, sp[15 * 65] * F8_W);
        *(u32x4*)(base + (size_t)rowmap(n0 + n, kind, N / 2) * ldd_bytes + k0 + 16 * c) = o; }
    asm volatile("s_waitcnt lgkmcnt(0)" ::: "memory");
}
__device__ __forceinline__ void transpose_job_f8(const Ctx& c_in, const float* W, size_t sstride, int nmat, int K, int N, unsigned char* WT8, size_t dstride_bytes, int kind) {
    LAUNDER(c_in);
    LAS float* scr = (LAS float*)(c.lds + c.wid * 16640);
    const int nblk = N / 64, per = (K / 64) * nblk, items = per * nmat;
    for (int it = c.gw; it < items; it += c.NGW) { const int mat = it / per, li = it - mat * per, k0 = 64 * (li / nblk), n0 = 64 * (li % nblk);
        const float* Wm = W + (size_t)mat * sstride; f32x4 v[16];
#pragma unroll
        for (int i = 0; i < 16; ++i) v[i] = *(const f32x4*)(Wm + (size_t)(k0 + 4 * i + (c.lane >> 4)) * N + n0 + 4 * (c.lane & 15));
        tr_store_f8(nullptr, (bf16*)(WT8 + (size_t)mat * dstride_bytes), k0, n0, N, K, kind, scr, c.lane, v); }
}
__device__ __forceinline__ void transpose_job(const Ctx& c_in, const float* W, size_t sstride, int nmat, int K, int N, bf16* WT, size_t dstride, int ldd, int row_off, int kind) {
    LAUNDER(c_in);
    LAS float* scr = (LAS float*)(c.lds + c.wid * 16640);
    const int per = (K / 64) * (N / 64), items = per * nmat;
    for (int it = c.gw; it < items; it += c.NGW) { const int mat = it / per;
        transpose_item(W + (size_t)mat * sstride, K, N, WT + (size_t)mat * dstride, ldd, row_off, kind, scr, it - mat * per, c.lane); }
}

__device__ __forceinline__ f32x2 cmul(f32x2 a, f32x2 b) { return (f32x2){a.x * b.x - a.y * b.y, a.x * b.y + a.y * b.x}; }

__device__ __forceinline__ void s5_tables(const Ctx& c_in, int l, int g) {
    LAUNDER(c_in);
    const Args& a = *c.a;
    LAS f32x2* AP = (LAS f32x2*)(c.lds);
    LAS f32x2* BB = (LAS f32x2*)(c.lds + 17408);
    LAS f32x2* CM = (LAS f32x2*)(c.lds + 33792);
    LAS float* KF = (LAS float*)(c.lds + 50176);
    __syncthreads();
    for (int i = c.tid; i < 2 * 64 * 17; i += 512) {
        const int k = i % 17, n = (i / 17) % 64, dir = i / (17 * 64);
        const size_t ia = ((size_t)(l * 2 + dir) * 16 + g) * 64 + n;
        const float are = a.in[I_SARE][ia], aim = a.in[I_SAIM][ia], dt = expf(a.in[I_SLDT][(l * 2 + dir) * 16 + g]);
        const float mag = expf(are * dt * (float)k), ang = aim * dt * (float)k;
        AP[i] = (f32x2){mag * cosf(ang), mag * sinf(ang)};
    }
    for (int i = c.tid; i < 2 * 64 * 16; i += 512) {
        const int q = i % 16, n = (i / 16) % 64, dir = i / (16 * 64);
        const size_t ia = ((size_t)(l * 2 + dir) * 16 + g) * 64 + n;
        const float are = a.in[I_SARE][ia], aim = a.in[I_SAIM][ia], dt = expf(a.in[I_SLDT][(l * 2 + dir) * 16 + g]);
        const float mag = expf(are * dt), ang = aim * dt;
        const f32x2 abm1 = (f32x2){mag * cosf(ang) - 1.f, mag * sinf(ang)};
        const float inv = 1.f / (are * are + aim * aim);
        const f32x2 coef = cmul(abm1, (f32x2){are * inv, -aim * inv});
        const f32x2 b = (f32x2){a.in[I_SBRE][ia * 16 + q], a.in[I_SBIM][ia * 16 + q]};
        BB[i] = cmul(coef, b);
    }
    for (int i = c.tid; i < 2 * 16 * 64; i += 512) {
        const int n = i % 64, p = (i / 64) % 16, dir = i / (64 * 16);
        const size_t ic = (((size_t)(l * 2 + dir) * 16 + g) * 16 + p) * 64 + n;
        CM[i] = (f32x2){a.in[I_SCRE][ic], a.in[I_SCIM][ic]};
    }
    __syncthreads();
    for (int i = c.tid; i < 2 * 16 * 256; i += 512) {
        const int q = i % 16, p = (i / 16) % 16, k = (i / 256) % 16, dir = i / 4096;
        float s = 0.f;
        for (int n = 0; n < 64; ++n) { const f32x2 e = cmul(CM[(dir * 16 + p) * 64 + n], AP[(dir * 64 + n) * 17 + k]); const f32x2 b = BB[(dir * 64 + n) * 16 + q]; s += e.x * b.x - e.y * b.y; }
        KF[i] = s;
    }
    __syncthreads();
    bf16* bt1 = (bf16*)(c.ws + WS_BT1) + (size_t)(l * 16 + g) * 256 * 256;
    bf16* bt3 = (bf16*)(c.ws + WS_BT3) + (size_t)(l * 16 + g) * 256 * 512;
    for (int i = c.tid; i < 256 * 256; i += 512) {
        const int kk = i % 256, j = i / 256, s = kk / 16, q = kk % 16, dir = j / 128, ri = (j / 64) & 1, n = j % 64;
        const f32x2 e = cmul(AP[(dir * 64 + n) * 17 + (dir == 0 ? 15 - s : s)], BB[(dir * 64 + n) * 16 + q]);
        bt1[i] = (bf16)f2bf(ri ? e.y : e.x);
    }
    const float* dvec = a.in[I_SD] + l * 256 + g * 16;
    for (int i = c.tid; i < 256 * 512; i += 512) {
        const int kk = i % 512, j = i / 512, t = j / 16, p = j % 16; float v;
        if (kk < 256) { const int s = kk / 16, q = kk % 16; v = 0.f;
            if (t >= s) v += KF[((0 * 16 + (t - s)) * 16 + p) * 16 + q];
            if (s >= t) v += KF[((1 * 16 + (s - t)) * 16 + p) * 16 + q];
            if (t == s && p == q) v += dvec[p];
        } else { const int k2 = kk - 256, dir = k2 / 128, ri = (k2 / 64) & 1, n = k2 % 64;
            const f32x2 e = cmul(CM[(dir * 16 + p) * 64 + n], AP[(dir * 64 + n) * 17 + (dir == 0 ? t + 1 : 16 - t)]);
            v = ri ? -e.y : e.x; }
        bt3[i] = (bf16)f2bf(v);
    }
    float* a16 = (float*)(c.ws + WS_A16);
    for (int i = c.tid; i < 128; i += 512) { const int dir = i / 64, n = i % 64; const f32x2 e = AP[(dir * 64 + n) * 17 + 16];
        a16[(((size_t)(l * 2 + dir) * 16 + g) * 64 + n) * 2] = e.x; a16[(((size_t)(l * 2 + dir) * 16 + g) * 64 + n) * 2 + 1] = e.y; }
    __syncthreads();
}

__device__ __forceinline__ void phase_prep(const Ctx& c_in) {
    LAUNDER(c_in);
    const Args& a = *c.a; unsigned char* ws = c.ws;
    for (int it = c.bid - 96; it >= 0 && it < DEPTH * 16; it += c.G) s5_tables(c, it / 16, it % 16);
    {
        LAS float* red = (LAS float*)c.lds;
        for (int it = c.bid; it < DEPTH * 48; it += c.G) {
            const int l = it / 48, cb = it % 48, col = cb * 128 + (c.tid & 127), ks = c.tid >> 7;
            float s[5] = {0.f, 0.f, 0.f, 0.f, 0.f};
            const float* w = a.in[I_ADAW] + (size_t)l * 1024 * 6144 + col;
            for (int k0 = ks * 256; k0 < ks * 256 + 256; k0 += 16) {
                float wv[16];
#pragma unroll
                for (int j = 0; j < 16; ++j) wv[j] = w[(size_t)(k0 + j) * 6144];
#pragma unroll
                for (int j = 0; j < 16; ++j) {
#pragma unroll
                    for (int r = 0; r < 5; ++r) { const float cv = r < 4 ? a.in[I_C][r * 1024 + k0 + j] : a.in[I_CCTX][k0 + j]; s[r] += cv * sigmoidf_(cv) * wv[j]; } }
            }
            __syncthreads();
#pragma unroll
            for (int r = 0; r < 5; ++r) red[(ks * 5 + r) * 128 + (c.tid & 127)] = s[r];
            __syncthreads();
            if (c.tid < 128) {
#pragma unroll
                for (int r = 0; r < 5; ++r) { const float v = red[(0 * 5 + r) * 128 + c.tid] + red[(1 * 5 + r) * 128 + c.tid] + red[(2 * 5 + r) * 128 + c.tid] + red[(3 * 5 + r) * 128 + c.tid] + a.in[I_ADAB][l * 6144 + col];
                    ((float*)(ws + WS_MODS))[(size_t)(l * 5 + r) * 6144 + col] = v; }
            }
        }
        __syncthreads();
    }
    if (c.bid == c.G - 1) {
        float* rope = (float*)(ws + WS_ROPE);
        for (int i = c.tid; i < 1040; i += 512) { const int pos = i / 16, j = i % 16; const float inv = powf(10000.f, -(float)j / 16.f), ang = pos < 64 ? (float)pos * inv : 0.f;
            rope[i] = cosf(ang); rope[1040 + i] = sinf(ang); }
    }
    for (int it = c.gw; it < DEPTH * 64; it += c.NGW) {
        const int l = it >> 6, ks = (it >> 1) & 31, nb = it & 1, j = c.lane & 15, kq = c.lane >> 4;
        const float* w = a.in[I_RW] + (size_t)l * D * NEXP + (size_t)(32 * ks + 8 * kq) * NEXP + 16 * nb + j;
        float wv[8]; unsigned hi[4], lo[4];
#pragma unroll
        for (int t = 0; t < 8; ++t) wv[t] = w[(size_t)t * NEXP];
#pragma unroll
        for (int t = 0; t < 4; ++t) { hi[t] = pk2(wv[2 * t], wv[2 * t + 1]); lo[t] = pk2(wv[2 * t] - bf2f(hi[t] & 0xffffu), wv[2 * t + 1] - bf2f(hi[t] >> 16)); }
        u32x4* dst = (u32x4*)(ws + WS_RWF) + (size_t)it * 128;
        dst[c.lane] = (u32x4){hi[0], hi[1], hi[2], hi[3]}; dst[64 + c.lane] = (u32x4){lo[0], lo[1], lo[2], lo[3]};
    }
    for (int i = c.gw * 64 + c.lane; i < DEPTH * 4 * 256 * 128; i += c.NGW * 64) {
        const int q = i % 128, p = (i / 128) % 256, lh = i / (128 * 256);
        ((bf16*)(ws + WS_WST))[i] = p < 128 ? (bf16)f2bf(a.in[I_GWS][((size_t)lh * 128 + p) * 128 + q]) : (bf16)0;
    }
    transpose_job_f8(c, a.in[I_W1], (size_t)D * 2048, DEPTH * NEXP, D, 2048, ws + WS_W1T, (size_t)2048 * D, 1);
    transpose_job_f8(c, a.in[I_W2], (size_t)D * D, DEPTH * NEXP, D, D, ws + WS_W2T, (size_t)D * D, 0);
    transpose_job_f8(c, a.in[I_WBG], (size_t)D * 4096, DEPTH, D, 4096, ws + WS_WBG8, (size_t)4096 * D, 0);
    transpose_job(c, a.in[I_WIN], (size_t)D * INW, DEPTH, D, INW, (bf16*)(ws + WS_WINT), (size_t)NG1 * D, D, 0, 0);
    transpose_job_f8(c, a.in[I_WBR], (size_t)256 * D, DEPTH * 4, 256, D, ws + WS_WBRT, (size_t)D * 256, 0);
    transpose_job(c, a.in[I_WOUT], (size_t)D * D, DEPTH, D, D, (bf16*)(ws + WS_WOUTT), (size_t)D * D, D, 0, 0);
    transpose_job(c, a.in[I_SWGLU], (size_t)256 * 512, DEPTH, 256, 512, (bf16*)(ws + WS_WGLUT), (size_t)512 * 256, 256, 0, 1);
}

__device__ __forceinline__ void load_row(const float* p, int lane, f32x4 (&v)[4]) {
#pragma unroll
    for (int j = 0; j < 4; ++j) v[j] = *(const f32x4*)(p + 4 * lane + 256 * j);
}
__device__ __forceinline__ void load_row_bf(const bf16* p, int lane, f32x4 (&v)[4]) {
#pragma unroll
    for (int j = 0; j < 4; ++j) { const u32x2 w = *(const u32x2*)(p + 4 * lane + 256 * j); v[j] = (f32x4){bf2f(w.x & 0xffffu), bf2f(w.x >> 16), bf2f(w.y & 0xffffu), bf2f(w.y >> 16)}; }
}
__device__ __forceinline__ float row_rms_scale(const f32x4 (&v)[4]) {
    float s = 0.f;
#pragma unroll
    for (int j = 0; j < 4; ++j) s += (v[j].x * v[j].x + v[j].y * v[j].y) + (v[j].z * v[j].z + v[j].w * v[j].w);
    return rsqrtf(wave_sum(s) * (1.f / D) + EPS);
}
template <bool WR_LDS, bool WR_H = true, bool WR_H8 = false>
__device__ __forceinline__ void norm_mod_store(const f32x4 (&x)[4], const float* gw, const float* shift, const float* scale, bf16* hrow, int lane, LAS float* hf, unsigned char* h8row = nullptr) {
    const float r = row_rms_scale(x);
#pragma unroll
    for (int j = 0; j < 4; ++j) {
        const int o = 4 * lane + 256 * j;
        const f32x4 g = *(const f32x4*)(gw + o), sh = *(const f32x4*)(shift + o), sc = *(const f32x4*)(scale + o);
        const f32x4 h = (x[j] * r * g) * (sc + 1.f) + sh;
        u32x2 w; w.x = pk2(h.x, h.y); w.y = pk2(h.z, h.w);
        if (WR_H) *(u32x2*)(hrow + o) = w;
        if (WR_H8) *(unsigned*)(h8row + o) = pk4_fp8(h.x * F8_X, h.y * F8_X, h.z * F8_X, h.w * F8_X);
        if (WR_LDS) { hf[o] = h.x; hf[o + 1] = h.y; hf[o + 2] = h.z; hf[o + 3] = h.w; }
    }
}
constexpr int N2_RS = 2064, N2_LO = 8320, N2_SLOT = 16640;
__device__ __forceinline__ void norm_mod_split(const f32x4 (&x)[4], const float* gw, const float* shift, const float* scale, int lane, LAS unsigned char* rowp) {
    const float r = row_rms_scale(x);
#pragma unroll
    for (int j = 0; j < 4; ++j) {
        const int o = 4 * lane + 256 * j;
        const f32x4 g = *(const f32x4*)(gw + o), sh = *(const f32x4*)(shift + o), sc = *(const f32x4*)(scale + o);
        const f32x4 h = (x[j] * r * g) * (sc + 1.f) + sh;
        u32x2 hi, lo; hi.x = pk2(h.x, h.y); hi.y = pk2(h.z, h.w);
        lo.x = pk2(h.x - bf2f(hi.x & 0xffffu), h.y - bf2f(hi.x >> 16)); lo.y = pk2(h.z - bf2f(hi.y & 0xffffu), h.w - bf2f(hi.y >> 16));
        *(LAS u32x2*)(rowp + o * 2) = hi; *(LAS u32x2*)(rowp + N2_LO + o * 2) = lo;
    }
}
__device__ __forceinline__ void phase_n1_layer0(const Ctx& c_in) {
    LAUNDER(c_in);
    const Args& a = *c.a;
    for (int row = c.gw; row < MT; row += c.NGW) {
        f32x4 x[4]; load_row(xin_row(a, row), c.lane, x);
        norm_mod_store<false, true, true>(x, a.in[I_NMPRE], mod_ptr(c.ws, 0, row, 0), mod_ptr(c.ws, 0, row, 1), (bf16*)(c.ws + WS_H) + (size_t)row * D, c.lane, nullptr, c.ws + WS_H8 + (size_t)row * D);
    }
}

using pg8::Unit;
struct SchedG1 {
    const char* A; const char* B; int nM, nMfull, nN, nNctx, G, c, Lbeg, Lend;
    __device__ __forceinline__ bool next(int i, Unit& u) const {
        const int L = Lbeg + i * G + c, n1 = nM * nNctx; int pm, pn;
        if (L >= Lend) return false;
        if (L < n1) { if (!pg8::plain_order(L, nM, nNctx, pm, pn)) return false; }
        else { if (!pg8::plain_order(L - n1, nMfull, nN - nNctx, pm, pn)) return false; pn += nNctx; }
        u.pm = pm; u.pn = pn; u.aux = 0; u.a = A + (size_t)pm * 256 * D * 2; u.b = B + (size_t)pn * 256 * D * 2; return true;
    }
};
struct SchedGate {
    const char* A; const char* B; int nMfull, G, c, rot;
    __device__ __forceinline__ bool next(int i, Unit& u) const {
        const int U = nMfull * 16, nfr = U / G, X = U - nfr * G, nl = G - rot; int L;
        if (i < nfr) L = i * G + c;
        else if (X <= 2 * nl) { const int x = 2 * (c - rot) + (i - nfr); if (c < rot || i - nfr > 1 || x >= X) return false; L = nfr * G + x; }
        else L = i * G + (c + G - rot) % G;
        int pm, pn; if (!pg8::plain_order(L, nMfull, 16, pm, pn)) return false;
        u.pm = pm; u.pn = 7 + pn; u.aux = 0; u.a = A + (size_t)pm * 256 * D; u.b = B + (size_t)pn * 256 * D; return true;
    }
};
struct PlainSched {
    const char* A; const char* B; int lda, ldb, nM, nN, G, c;
    __device__ __forceinline__ bool next(int i, Unit& u) const {
        int pm, pn; if (!pg8::plain_order(i * G + c, nM, nN, pm, pn)) return false;
        u.pm = pm; u.pn = pn; u.aux = 0; u.a = A + (size_t)pm * 256 * lda * 2; u.b = B + (size_t)pn * 256 * ldb * 2; return true;
    }
};
#define EPI_ROWCOL const int row = row_; const int col = u.pn * 256 + bj * 128 + wc * 32 + n * 16 + fq * 4;
#define EPI_FENCE asm volatile("" ::: "memory")
#define EPI_ROW_OPAQUE int row_ = u.pm * 256 + ai * 128 + wr * 64 + m * 16 + fr; asm volatile("" : "+v"(row_));
#define EPI_LOOP4(...) _Pragma("unroll") for (int ai = 0; ai < 2; ++ai) _Pragma("unroll") for (int m = 0; m < 4; ++m) { EPI_ROW_OPAQUE _Pragma("unroll") for (int bj = 0; bj < 2; ++bj) _Pragma("unroll") for (int n = 0; n < 2; ++n) { __VA_ARGS__ } EPI_FENCE; }
__device__ __forceinline__ u32x4 pack8_swap(f32x4 v0, f32x4 v1) {
    const unsigned x0 = pk2(v0.x, v0.y), x1 = pk2(v0.z, v0.w), y0 = pk2(v1.x, v1.y), y1 = pk2(v1.z, v1.w);
    const u32x2 r0 = __builtin_amdgcn_permlane16_swap(x0, y0, false, false), r1 = __builtin_amdgcn_permlane16_swap(x1, y1, false, false);
    return (u32x4){r0.x, r1.x, r0.y, r1.y};
}
__device__ __forceinline__ void st_bf4(bf16* p, f32x4 v) { u32x2 w; w.x = pk2(v.x, v.y); w.y = pk2(v.z, v.w); *(u32x2*)p = w; }

struct EpiG1 {
    unsigned char* ws; const float* bbg; const float* rope;
    __device__ __forceinline__ void operator()(const f32x4 (&acc)[2][2][4][2], const Unit& u, int wr, int wc, int fr, int fq) const {
        bf16* P = (bf16*)(ws + WS_P);
        if (u.pn >= 7) {
            bf16* GT = (bf16*)(ws + WS_GATES);
            const int cs = (fq & 1) ? 12 + 4 * fq : 4 * fq;
#pragma unroll
            for (int ai = 0; ai < 2; ++ai)
#pragma unroll
                for (int m = 0; m < 4; ++m) { EPI_ROW_OPAQUE
#pragma unroll
                    for (int bj = 0; bj < 2; ++bj) { const int gc0 = u.pn * 256 + bj * 128 + wc * 32 - INW;
                        const f32x4 v0 = acc[ai][bj][m][0] * (1.f / (F8_W * F8_X)) + *(const f32x4*)(bbg + gc0 + fq * 4), v1 = acc[ai][bj][m][1] * (1.f / (F8_W * F8_X)) + *(const f32x4*)(bbg + gc0 + 16 + fq * 4);
                        const unsigned q0 = pk4_u8(sigmoid_g(v0.x), sigmoid_g(v0.y), sigmoid_g(v0.z), sigmoid_g(v0.w));
                        const unsigned q1 = pk4_u8(sigmoid_g(v1.x), sigmoid_g(v1.y), sigmoid_g(v1.z), sigmoid_g(v1.w));
                        *(u32x2*)((unsigned char*)GT + (size_t)row_ * 4096 + gc0 + cs) = __builtin_amdgcn_permlane16_swap(q0, q1, false, false); }
                    EPI_FENCE; }
        } else if (u.pn == 1) {
            bf16* AC = (bf16*)(ws + WS_ACAT);
            EPI_LOOP4( EPI_ROWCOL const int cc = col - 256; st_bf4(AC + ((size_t)(row >> 4) * 16 + (cc >> 4)) * 512 + (row & 15) * 16 + (cc & 15), acc[ai][bj][m][n]); )
        } else if (u.pn == 2 || u.pn == 3) {
            const int cs8 = (fq & 1) ? 12 + 4 * fq : 4 * fq;
#pragma unroll
            for (int ai = 0; ai < 2; ++ai)
#pragma unroll
                for (int m = 0; m < 4; ++m) { EPI_ROW_OPAQUE
#pragma unroll
                    for (int bj = 0; bj < 2; ++bj) { const f32x4 v0 = acc[ai][bj][m][0], v1 = acc[ai][bj][m][1];
                        *(u32x4*)(P + (size_t)row_ * INW + u.pn * 256 + bj * 128 + wc * 32 + cs8) = pack8_swap((f32x4){gelu_tanh(v0.x), gelu_tanh(v0.y), gelu_tanh(v0.z), gelu_tanh(v0.w)},
                                                                                                                 (f32x4){gelu_tanh(v1.x), gelu_tanh(v1.y), gelu_tanh(v1.z), gelu_tanh(v1.w)}); }
                    EPI_FENCE; }
        } else if (u.pn == 4 || u.pn == 5) {
            const float qs = u.pn == 4 ? 0.125f : 1.f;
            const int cs8 = (fq & 1) ? 12 + 4 * fq : 4 * fq;
#pragma unroll
            for (int ai = 0; ai < 2; ++ai) {
                f32x4 cs[4], sn[4]; int rows[4];
#pragma unroll
                for (int m = 0; m < 4; ++m) { EPI_ROW_OPAQUE rows[m] = row_;
                    const int t = row_ & (SEQ - 1), pos = row_ < NLAT ? ((wc & 1) ? (t & 63) : (t >> 6)) : 64;
                    cs[m] = *(const f32x4*)(rope + pos * 16 + 4 * fq); sn[m] = *(const f32x4*)(rope + 1040 + pos * 16 + 4 * fq); }
#pragma unroll
                for (int m = 0; m < 4; ++m) {
#pragma unroll
                    for (int bj = 0; bj < 2; ++bj) {
                        const f32x4 x1 = acc[ai][bj][m][0], x2 = acc[ai][bj][m][1];
                        *(u32x4*)(P + (size_t)rows[m] * INW + u.pn * 256 + bj * 128 + wc * 32 + cs8) = pack8_swap((x1 * cs[m] - x2 * sn[m]) * qs, (x2 * cs[m] + x1 * sn[m]) * qs);
                    }
                }
                EPI_FENCE;
            }
        } else if (u.pn == 6) {
            bf16* VT2 = (bf16*)(ws + WS_VT2);
            EPI_LOOP4( EPI_ROWCOL const f32x4 v = acc[ai][bj][m][n]; bf16* vp = VT2 + (size_t)(col - 1536) * MT + row;
                vp[0] = (bf16)f2bf(v.x); vp[MT] = (bf16)f2bf(v.y); vp[2 * MT] = (bf16)f2bf(v.z); vp[3 * MT] = (bf16)f2bf(v.w); )
        } else {
            const int cs8 = (fq & 1) ? 12 + 4 * fq : 4 * fq;
#pragma unroll
            for (int ai = 0; ai < 2; ++ai)
#pragma unroll
                for (int m = 0; m < 4; ++m) { EPI_ROW_OPAQUE
#pragma unroll
                    for (int bj = 0; bj < 2; ++bj) *(u32x4*)(P + (size_t)row_ * INW + u.pn * 256 + bj * 128 + wc * 32 + cs8) = pack8_swap(acc[ai][bj][m][0], acc[ai][bj][m][1]);
                    EPI_FENCE; }
        }
    }
};
struct SchedS5 {
    const char* A; const char* B; int Kb, G, c;
    __device__ __forceinline__ bool next(int i, Unit& u) const {
        const int L = i * G + c; if (L >= 80) return false;
        u.pm = L % 5; u.aux = L / 5; u.pn = 0; u.a = A + ((size_t)u.pm * 256 * 8192 + u.aux * 512) * 2; u.b = B + (size_t)u.aux * 256 * Kb * 2; return true;
    }
};
struct EpiS1 {
    float* sst;
    __device__ __forceinline__ void operator()(const f32x4 (&acc)[2][2][4][2], const Unit& u, int wr, int wc, int fr, int fq) const {
        EPI_LOOP4( EPI_ROWCOL if (row < NCHUNK) *(f32x4*)(sst + ((size_t)row * 16 + u.aux) * 256 + col) = acc[ai][bj][m][n]; )
    }
};
struct EpiS3 {
    bf16* yg;
    __device__ __forceinline__ void operator()(const f32x4 (&acc)[2][2][4][2], const Unit& u, int wr, int wc, int fr, int fq) const {
        EPI_LOOP4( EPI_ROWCOL if (row < NCHUNK) { const f32x4 v = acc[ai][bj][m][n];
            st_bf4(yg + ((size_t)row * 16 + (col >> 4)) * 256 + u.aux * 16 + (col & 15), (f32x4){gelu_tanh(v.x), gelu_tanh(v.y), gelu_tanh(v.z), gelu_tanh(v.w)}); } )
    }
};
struct EpiGLU {
    bf16* br;
    __device__ __forceinline__ void operator()(const f32x4 (&acc)[2][2][4][2], const Unit& u, int wr, int wc, int fr, int fq) const {
#pragma unroll
        for (int ai = 0; ai < 2; ++ai)
#pragma unroll
            for (int m = 0; m < 4; ++m) { EPI_ROW_OPAQUE
#pragma unroll
                for (int n = 0; n < 2; ++n) {
                    const int row = row_, colh = wc * 32 + n * 16 + fq * 4;
                    const f32x4 v = acc[ai][0][m][n], g = acc[ai][1][m][n];
                    *(unsigned*)((unsigned char*)br + (size_t)row * D + 256 + u.pn * 128 + colh) = pk4_fp8(v.x * sigmoidf_(g.x) * F8_B, v.y * sigmoidf_(g.y) * F8_B, v.z * sigmoidf_(g.z) * F8_B, v.w * sigmoidf_(g.w) * F8_B);
                } EPI_FENCE; }
    }
};
struct SchedGM {
    const char* A; const char* B; int G, c;
    __device__ __forceinline__ bool next(int i, Unit& u) const {
        const int L = i * G + c; if (c < 0 || L >= 136) return false;
        u.pm = L % 34; u.aux = L / 34; u.pn = 0; u.a = A + ((size_t)u.aux * 8704 + (size_t)u.pm * 256) * 128 * 2; u.b = B + (size_t)u.aux * 256 * 128 * 2; return true;
    }
};
struct EpiGM {
    const bf16* P; bf16* br; const float* bs;
    __device__ __forceinline__ void operator()(const f32x4 (&acc)[2][2][4][2], const Unit& u, int wr, int wc, int fr, int fq) const {
        const int h = u.aux;
#pragma unroll
        for (int ai = 0; ai < 2; ++ai)
#pragma unroll
            for (int m = 0; m < 4; ++m) { EPI_ROW_OPAQUE
#pragma unroll
                for (int n = 0; n < 2; ++n) {
                    const int row = row_, chunk = row >> 6, ch = row & 63, p0 = wc * 32 + n * 16 + fq * 4;
                    const f32x4 v = acc[ai][0][m][n];
#pragma unroll
                    for (int j = 0; j < 4; ++j) { const int tok = chunk * 128 + p0 + j; const size_t o = (size_t)tok * INW + 512 + h * 64 + ch;
                        br[(size_t)tok * D + 512 + h * 64 + ch] = (bf16)f2bf((v[j] + bs[h * 128 + p0 + j]) * bf2f(P[o])); }
                } EPI_FENCE; }
    }
};
struct SchedG2 {
    const char* A; const char* B; int G, c;
    __device__ __forceinline__ bool next(int i, Unit& u) const {
        const int tile = (i >> 2) * G + c; if (tile >= 68 * 4) return false;
        u.aux = i & 3; u.pm = tile >> 2; u.pn = tile & 3; u.a = A + ((size_t)u.pm * 256 * D + u.aux * 256) * 2; u.b = B + ((size_t)u.aux * D * 256 + (size_t)u.pn * 256 * 256) * 2; return true;
    }
};
struct EpiG2 {
    const bf16* gates; float* mrgf; bf16* mrg;
    __device__ __forceinline__ void operator()(const f32x4 (&acc)[2][2][4][2], const Unit& u, int wr, int wc, int fr, int fq) const {
        const int i = u.aux;
        EPI_LOOP4( EPI_ROWCOL const u32x2 gw = *(const u32x2*)(gates + (size_t)row * 4096 + i * 1024 + col);
            const f32x4 g = (f32x4){bf2f(gw.x & 0xffffu), bf2f(gw.x >> 16), bf2f(gw.y & 0xffffu), bf2f(gw.y >> 16)};
            f32x4 v = acc[ai][bj][m][n] * g; float* mp = mrgf + (size_t)row * D + col;
            if (i > 0) v += *(const f32x4*)mp;
            if (i < 3) *(f32x4*)mp = v; else st_bf4(mrg + (size_t)row * D + col, v); )
    }
};
struct EpiBF {
    bf16* o; int ldc;
    __device__ __forceinline__ void operator()(const f32x4 (&acc)[2][2][4][2], const Unit& u, int wr, int wc, int fr, int fq) const {
        const int cs = (fq & 1) ? 12 + 4 * fq : 4 * fq;
#pragma unroll
        for (int ai = 0; ai < 2; ++ai)
#pragma unroll
            for (int m = 0; m < 4; ++m) { EPI_ROW_OPAQUE
#pragma unroll
                for (int bj = 0; bj < 2; ++bj) *(u32x4*)(o + (size_t)row_ * ldc + u.pn * 256 + bj * 128 + wc * 32 + cs) = pack8_swap(acc[ai][bj][m][0], acc[ai][bj][m][1]);
                EPI_FENCE; }
    }
};
struct EpiF32 {
    float* o; int ldc;
    __device__ __forceinline__ void operator()(const f32x4 (&acc)[2][2][4][2], const Unit& u, int wr, int wc, int fr, int fq) const {
        EPI_LOOP4( EPI_ROWCOL *(f32x4*)(o + (size_t)row * ldc + col) = acc[ai][bj][m][n]; )
    }
};
struct SchedMoE {
    const char* A; const char* B; const LAS int* ts; int nN, G, c; size_t bstride; bool a_sparse;
    __device__ __forceinline__ bool next(int i, Unit& u) const {
        const int nt = ts[32]; int j, pn;
        if (nN == 8 && (G & 7) == 0) {
            const int x = c & 7, k = i * (G >> 3) + (c >> 3);
            j = 2 * (k >> 1) + (x >> 2); pn = 2 * (x & 3) + (k & 1); if (j >= nt) return false;
        } else { const int L = i * G + c; if (L >= nt * nN) return false; j = L / nN; pn = L % nN; }
        int e = 0;
#pragma unroll
        for (int st = 16; st >= 1; st >>= 1) if (ts[e + st] <= j) e += st;
        const size_t arow = a_sparse ? (size_t)e * MOE_CAP + (size_t)(j - ts[e]) * 256 : (size_t)j * 256;
        u.pm = j; u.pn = pn; u.aux = e; u.a = A + arow * D; u.b = B + (size_t)e * bstride + (size_t)u.pn * 256 * D; return true;
    }
};
struct EpiE1 {
    bf16* act; const float* b1;
    __device__ __forceinline__ void operator()(const f32x4 (&acc)[2][2][4][2], const Unit& u, int wr, int wc, int fr, int fq) const {
        const float* bb = b1 + (size_t)u.aux * 2048;
        f32x4 bg[2], bl[2];
#pragma unroll
        for (int n = 0; n < 2; ++n) { const int c0 = u.pn * 128 + wc * 32 + n * 16 + fq * 4; bg[n] = *(const f32x4*)(bb + c0); bl[n] = (*(const f32x4*)(bb + 1024 + c0) + 1.f) * F8_ACT; }
#pragma unroll
        for (int ai = 0; ai < 2; ++ai)
#pragma unroll
            for (int m = 0; m < 4; ++m) { EPI_ROW_OPAQUE
                unsigned pq[2];
#pragma unroll
                for (int n = 0; n < 2; ++n) {
                    const f32x4 hg = acc[ai][0][m][n] * (1.f / (F8_W * F8_X)) + bg[n], hl = acc[ai][1][m][n] * (F8_ACT / (F8_W * F8_X)) + bl[n];
                    f32x4 o;
#pragma unroll
                    for (int j = 0; j < 4; ++j) { const float g = fminf(hg[j], 7.f), li4 = __builtin_amdgcn_fmed3f(hl[j], -6.f * F8_ACT, 8.f * F8_ACT);
                        const float sg = __builtin_amdgcn_rcpf(1.f + __builtin_amdgcn_exp2f(g * (-1.702f * 1.4426950408889634f))); o[j] = (g * sg) * li4; }
                    pq[n] = pk4_fp8_nc(o[0], o[1], o[2], o[3]);
                }
                { const u32x2 r = __builtin_amdgcn_permlane16_swap(pq[0], pq[1], false, false);
                  *(u32x2*)((unsigned char*)act + (size_t)row_ * D + u.pn * 128 + wc * 32 + ((fq & 1) ? 12 + 4 * fq : 4 * fq)) = r; }
                EPI_FENCE; }
    }
};
struct EpiE2 {
    bf16* yb; const float* b2;
    __device__ __forceinline__ void operator()(const f32x4 (&acc)[2][2][4][2], const Unit& u, int wr, int wc, int fr, int fq) const {
        const float* bb = b2 + (size_t)u.aux * 1024;
        f32x4 bv[2][2];
#pragma unroll
        for (int bj = 0; bj < 2; ++bj)
#pragma unroll
            for (int n = 0; n < 2; ++n) bv[bj][n] = *(const f32x4*)(bb + u.pn * 256 + bj * 128 + wc * 32 + n * 16 + fq * 4);
        const int cs = (fq & 1) ? 12 + 4 * fq : 4 * fq;
#pragma unroll
        for (int ai = 0; ai < 2; ++ai)
#pragma unroll
            for (int m = 0; m < 4; ++m) { EPI_ROW_OPAQUE
#pragma unroll
                for (int bj = 0; bj < 2; ++bj) { const f32x4 v0 = acc[ai][bj][m][0] * (F8_Y / (F8_W * F8_ACT)) + bv[bj][0] * F8_Y, v1 = acc[ai][bj][m][1] * (F8_Y / (F8_W * F8_ACT)) + bv[bj][1] * F8_Y;
                    const u32x2 r = __builtin_amdgcn_permlane16_swap(pk4_fp8(v0.x, v0.y, v0.z, v0.w), pk4_fp8(v1.x, v1.y, v1.z, v1.w), false, false);
                    *(u32x2*)((unsigned char*)yb + (size_t)row_ * D + u.pn * 256 + bj * 128 + wc * 32 + cs) = r; }
                EPI_FENCE; }
    }
};


__device__ __forceinline__ void gemm_merge(LAS unsigned char* lds, const char* BRp, const char* WBRTp, const bf16* gates, bf16* mrg, int nMt, int G, int cid) {
    using namespace pg8;
    int tid_ = threadIdx.x; asm volatile("" : "+v"(tid_));
    const int tid = tid_, wid = __builtin_amdgcn_readfirstlane(tid >> 6), lane = tid & 63, wr = wid >> 2, wc = wid & 3, fr = lane & 15, fq = lane >> 4;
    unsigned voffA[2], voffB[2];
#pragma unroll
    for (int i = 0; i < 2; ++i) { int R, C; stage_rc(tid * 16 + i * 8192, R, C); voffA[i] = (unsigned)(R * D + C * 2); voffB[i] = (unsigned)(R * 256 + C * 2); }
    const unsigned ldsw = (unsigned)wid * 1024u;
    const int aoff = lds_byte(wr * 64 + fr, fq * 8), boff = lds_byte(wc * 32 + fr, fq * 8);
#define GM_SA(b, h) (((b) * 2 + (h)) * HTB)
#define GM_SB(b) ((4 + (b) * 2) * HTB)
#define GM_STAGE(bufoff, gbase, voff) do { _Pragma("unroll") for (int _i = 0; _i < 2; ++_i) \
        __builtin_amdgcn_global_load_lds((const unsigned*)((const char*)(gbase) + (voff)[_i]), (LAS unsigned*)(lds + (bufoff) + ldsw + _i * 8192), 16, 0, 0); } while (0)
#define GM_LD8(p_) ({ const u32x4 lo_ = *(const LAS u32x4*)(p_), hi_ = *(const LAS u32x4*)((p_) + 1024); (v8i32){(int)lo_.x, (int)lo_.y, (int)lo_.z, (int)lo_.w, (int)hi_.x, (int)hi_.y, (int)hi_.z, (int)hi_.w}; })
    for (int L = cid; L < nMt * 8; L += G) {
        const int pm = L >> 3, pn2 = L & 7;
        const char* cA = uptr(BRp + (size_t)pm * 256 * D);
        const char* cB = uptr(WBRTp + (size_t)pn2 * 128 * 256);
        f32x4 acc[2][4][2], mg[2][4][2];
#pragma unroll
        for (int a = 0; a < 2; ++a)
#pragma unroll
            for (int m = 0; m < 4; ++m)
#pragma unroll
                for (int n = 0; n < 2; ++n) { acc[a][m][n] = (f32x4){0.f, 0.f, 0.f, 0.f}; mg[a][m][n] = (f32x4){0.f, 0.f, 0.f, 0.f}; }
#define GM_STAGE_TILE(t, b) do { const char* a_ = cA + (size_t)(t) * 128; const char* b_ = cB + (size_t)((t) >> 1) * (1024 * 256) + (size_t)((t) & 1) * 128; \
        asm volatile("" : "+s"(a_), "+s"(b_)); GM_STAGE(GM_SA(b, 0), a_, voffA); GM_STAGE(GM_SA(b, 1), a_ + (size_t)128 * D, voffA); GM_STAGE(GM_SB(b), b_, voffB); } while (0)
        GM_STAGE_TILE(0, 0); GM_STAGE_TILE(1, 1);
        asm volatile("s_waitcnt vmcnt(6)" ::: "memory"); __builtin_amdgcn_s_barrier();
        unsigned gpre[2][4][2];
#pragma unroll
        for (int t = 0; t < 8; ++t) {
            const int b = t & 1;
            if ((t & 1) == 0) {
                const int i = t >> 1;
#pragma unroll
                for (int ai = 0; ai < 2; ++ai)
#pragma unroll
                    for (int m = 0; m < 4; ++m) {
                        int row_ = pm * 256 + ai * 128 + wr * 64 + m * 16 + fr; asm volatile("" : "+v"(row_));
#pragma unroll
                        for (int n = 0; n < 2; ++n) gpre[ai][m][n] = *(const unsigned*)((const unsigned char*)gates + (size_t)row_ * 4096 + i * 1024 + pn2 * 128 + wc * 32 + n * 16 + fq * 4);
                    }
            }
            v8i32 At[4], B0[2];
#pragma unroll
            for (int n = 0; n < 2; ++n) B0[n] = GM_LD8(lds + GM_SB(b) + boff + n * 2048);
#pragma unroll
            for (int ai = 0; ai < 2; ++ai) {
#pragma unroll
                for (int m = 0; m < 4; ++m) At[m] = GM_LD8(lds + GM_SA(b, ai) + aoff + m * 2048);
                asm volatile("s_waitcnt lgkmcnt(0)" ::: "memory");
#pragma unroll
                for (int m = 0; m < 4; ++m)
#pragma unroll
                    for (int n = 0; n < 2; ++n)
                        asm volatile("s_nop 1\n\tv_mfma_f32_16x16x128_f8f6f4 %0, %1, %2, %0" : "+v"(acc[ai][m][n]) : "v"(B0[n]), "v"(At[m]));
                asm volatile("s_nop 7" ::: "memory");
            }
            __builtin_amdgcn_s_barrier();
            if (t + 2 < 8) { GM_STAGE_TILE(t + 2, b); if ((t & 1) == 0) asm volatile("s_waitcnt vmcnt(22)" ::: "memory"); else asm volatile("s_waitcnt vmcnt(6)" ::: "memory"); }
            else asm volatile("s_waitcnt vmcnt(0)" ::: "memory");
            __builtin_amdgcn_s_barrier();
            if ((t & 1) == 1) {
                asm volatile("s_nop 15\n\ts_nop 15" ::: "memory");
#pragma unroll
                for (int ai = 0; ai < 2; ++ai)
#pragma unroll
                    for (int m = 0; m < 4; ++m)
#pragma unroll
                        for (int n = 0; n < 2; ++n) asm volatile("" : "+v"(acc[ai][m][n]));
#pragma unroll
                for (int ai = 0; ai < 2; ++ai)
#pragma unroll
                    for (int m = 0; m < 4; ++m)
#pragma unroll
                        for (int n = 0; n < 2; ++n) {
                            const unsigned gw = gpre[ai][m][n];
                            const f32x4 g = (f32x4){(float)(gw & 0xffu), (float)((gw >> 8) & 0xffu), (float)((gw >> 16) & 0xffu), (float)(gw >> 24)} * (1.f / (F8_G * F8_W * F8_B));
                            mg[ai][m][n] += acc[ai][m][n] * g; acc[ai][m][n] = (f32x4){0.f, 0.f, 0.f, 0.f};
                        }
            }
        }
#pragma unroll
        for (int ai = 0; ai < 2; ++ai)
#pragma unroll
            for (int m = 0; m < 4; ++m) {
                int row_ = pm * 256 + ai * 128 + wr * 64 + m * 16 + fr; asm volatile("" : "+v"(row_));
                *(u32x4*)(mrg + (size_t)row_ * D + pn2 * 128 + wc * 32 + ((fq & 1) ? 12 + 4 * fq : 4 * fq)) = pack8_swap(mg[ai][m][0], mg[ai][m][1]);
            }
    }
#undef GM_LD8
#undef GM_SA
#undef GM_SB
#undef GM_STAGE
#undef GM_STAGE_TILE
}

template <int G>
__device__ __forceinline__ void pool_item(const Ctx& c, int l, int blk, int hf, const bf16x8 (&wf)[4][2], const f32x4 (&psc)[4], LAS unsigned char* tile) {
    constexpr int H = 1 << G, NV = 32 + 2 * H;
    const bf16* P = (const bf16*)(c.ws + WS_P); bf16* br = (bf16*)(c.ws + WS_BR8);
    const int row0 = blk * 64 + hf * 32;
    int base, Lq;
    if (row0 < NLAT) { base = row0 & ~(SEQ - 1); Lq = SEQ; } else { base = NLAT + ((row0 - NLAT) & ~(CTXL - 1)); Lq = CTXL; }
    const int tq = row0 - base;
    float v[NV];
#pragma unroll
    for (int jj = 0; jj < NV; ++jj) { const int j = tq - H + jj; const bool ok = j >= 0 && j < Lq;
        v[jj] = ok ? bf2f(P[(size_t)(base + (ok ? j : 0)) * INW + G * 64 + c.lane]) : 0.f; }
    float run = 0.f, lo_[32];
    float S[NV + 1];
    S[0] = 0.f;
#pragma unroll
    for (int k = 0; k < NV; ++k) { run += v[k]; S[k + 1] = run; }
    (void)lo_;
#pragma unroll
    for (int i = 0; i < 32; ++i) {
        const int t = tq + i; int lo = t - H, hi = t + H; lo = lo < 0 ? 0 : lo; hi = hi > Lq ? Lq : hi;
        const float d = (S[i + 2 * H] - S[i]) * (1.f / (float)(hi - lo)) - v[i + H];
        *(LAS bf16*)(tile + i * 144 + c.lane * 2) = (bf16)f2bf(d);
    }
    asm volatile("s_waitcnt lgkmcnt(0)" ::: "memory");
    const int fr = c.lane & 15, fq = c.lane >> 4;
    f32x4 acc[2][4];
#pragma unroll
    for (int mb = 0; mb < 2; ++mb)
#pragma unroll
        for (int nb = 0; nb < 4; ++nb) acc[mb][nb] = (f32x4){0.f, 0.f, 0.f, 0.f};
#pragma unroll
    for (int mb = 0; mb < 2; ++mb)
#pragma unroll
        for (int kh = 0; kh < 2; ++kh) {
            const bf16x8 df = *(const LAS bf16x8*)(tile + (16 * mb + fr) * 144 + (32 * kh + 8 * fq) * 2);
#pragma unroll
            for (int nb = 0; nb < 4; ++nb) acc[mb][nb] = __builtin_amdgcn_mfma_f32_16x16x32_bf16(wf[nb][kh], df, acc[mb][nb], 0, 0, 0);
        }
#pragma unroll
    for (int mb = 0; mb < 2; ++mb)
#pragma unroll
        for (int nb = 0; nb < 4; ++nb) { const f32x4 v_ = acc[mb][nb] * psc[nb] * F8_B; *(unsigned*)((unsigned char*)br + (size_t)(row0 + 16 * mb + fr) * D + G * 64 + 16 * nb + 4 * fq) = pk4_fp8(v_.x, v_.y, v_.z, v_.w); }
    asm volatile("s_waitcnt lgkmcnt(0)" ::: "memory");
}
template <int G>
__device__ __forceinline__ void pool_wave(const Ctx& c, int l, int nblk, int hf, LAS unsigned char* tile) {
    const Args& a = *c.a;
    const int fr = c.lane & 15, fq = c.lane >> 4;
    const float* W = a.in[I_POOLW] + ((size_t)l * 4 + G) * 4096;
    bf16x8 wf[4][2]; f32x4 psc[4];
#pragma unroll
    for (int nb = 0; nb < 4; ++nb) {
#pragma unroll
        for (int kh = 0; kh < 2; ++kh) {
            float w8[8];
#pragma unroll
            for (int e = 0; e < 8; ++e) w8[e] = W[(32 * kh + 8 * fq + e) * 64 + 16 * nb + fr];
            u32x4 pk; pk.x = pk2(w8[0], w8[1]); pk.y = pk2(w8[2], w8[3]); pk.z = pk2(w8[4], w8[5]); pk.w = pk2(w8[6], w8[7]);
            wf[nb][kh] = __builtin_bit_cast(bf16x8, pk);
        }
        psc[nb] = *(const f32x4*)(a.in[I_POOLS] + l * 256 + G * 64 + 16 * nb + 4 * fq);
    }
    for (int blk = c.bid; blk < nblk; blk += c.G) pool_item<G>(c, l, blk, hf, wf, psc, tile);
}
__device__ __forceinline__ void phase_pool(const Ctx& c_in, int l) {
    LAUNDER(c_in);
    __syncthreads();
    LAS unsigned char* tile = c.lds + c.wid * 4608;
    const int g = c.wid & 3, hf = c.wid >> 2, nblk = (l == DEPTH - 1) ? NLAT / 64 : MT / 64;
    if (g == 0) pool_wave<0>(c, l, nblk, hf, tile);
    else if (g == 1) pool_wave<1>(c, l, nblk, hf, tile);
    else if (g == 2) pool_wave<2>(c, l, nblk, hf, tile);
    else pool_wave<3>(c, l, nblk, hf, tile);
    __syncthreads();
}
__device__ __forceinline__ void phase_gmlp_ln(const Ctx& c_in, int l) {
    LAUNDER(c_in);
    const Args& a = *c.a;
    LAS bf16* tl = (LAS bf16*)c.lds;
    const bf16* P = (const bf16*)(c.ws + WS_P); bf16* VT = (bf16*)(c.ws + WS_VT);
    for (int chunk = c.bid; chunk < MT / 128; chunk += c.G) {
        __syncthreads();
        for (int q = c.wid; q < 128; q += 8) {
            const int row = chunk * 128 + q;
            const u32x2 w = *(const u32x2*)(P + (size_t)row * INW + 768 + 4 * c.lane);
            f32x4 v = (f32x4){bf2f(w.x & 0xffffu), bf2f(w.x >> 16), bf2f(w.y & 0xffffu), bf2f(w.y >> 16)};
            const float mu = wave_sum((v.x + v.y) + (v.z + v.w)) * (1.f / 256.f);
            v = v - mu;
            const float var = wave_sum((v.x * v.x + v.y * v.y) + (v.z * v.z + v.w * v.w)) * (1.f / 256.f);
            const float r = rsqrtf(var + EPS);
            const f32x4 g = *(const f32x4*)(a.in[I_LNG] + l * 256 + 4 * c.lane), b = *(const f32x4*)(a.in[I_LNB] + l * 256 + 4 * c.lane);
            v = v * r * g + b;
#pragma unroll
            for (int j = 0; j < 4; ++j) tl[(4 * c.lane + j) * 130 + q] = (bf16)f2bf(v[j]);
        }
        __syncthreads();
        for (int i = c.tid; i < 256 * 64; i += 512) {
            const int ch = i >> 6, q2 = i & 63, h = ch >> 6, cc = ch & 63;
            const unsigned w = (unsigned)tl[ch * 130 + 2 * q2] | ((unsigned)tl[ch * 130 + 2 * q2 + 1] << 16);
            *(unsigned*)(VT + ((size_t)h * 8704 + (size_t)chunk * 64 + cc) * 128 + 2 * q2) = w;
        }
    }
    __syncthreads();
}
__device__ __forceinline__ void phase_attn(const Ctx& c_in, int l, bool with_ctx_q) {
    LAUNDER(c_in);
    const Args& a = *c.a;
    LAS float* pw = (LAS float*)(c.lds) + c.wid * 512;
    const bf16* P = (const bf16*)(c.ws + WS_P); bf16* br = (bf16*)(c.ws + WS_BR);
    const float* rpb = a.in[I_RPB] + (size_t)l * 4 * 15 * 31;
    const int nq = with_ctx_q ? MT : NLAT;
    for (int it = c.gw; it < nq * 4; it += c.NGW) {
        const int row = it >> 2, h = it & 3;
        const bool lat = row < NLAT;
        const int b = lat ? row / SEQ : (row - NLAT) / CTXL;
        int r = 0, ci = 0, rs = 0, cs = 0;
        if (lat) { const int t = row & (SEQ - 1); r = t >> 6; ci = t & 63; rs = r - 4; rs = rs < 0 ? 0 : (rs > 56 ? 56 : rs); cs = ci - 8; cs = cs < 0 ? 0 : (cs > 48 ? 48 : cs); }
        u32x4 qp[8];
        { const bf16* qptr = P + (size_t)row * INW + 1024 + h * 64;
#pragma unroll
          for (int j = 0; j < 8; ++j) qp[j] = *(const u32x4*)(qptr + 8 * j); }
        float sc[6];
#pragma unroll
        for (int kb = 0; kb < 6; ++kb) {
            int krow; float bias = 0.f; bool valid = true;
            if (kb < 2) { const int i = kb * 64 + c.lane, jr = i >> 4, jc = i & 15, kr = rs + jr, kc = cs + jc;
                krow = b * SEQ + kr * 64 + kc; bias = rpb[(h * 15 + (kr - r + 7)) * 31 + (kc - ci + 15)]; valid = lat; if (!lat) krow = row; }
            else krow = NLAT + b * CTXL + (kb - 2) * 64 + c.lane;
            const bf16* kp = P + (size_t)krow * INW + 1280 + h * 64; float s = 0.f;
#pragma unroll
            for (int j = 0; j < 8; ++j) { const u32x4 w = *(const u32x4*)(kp + 8 * j);
#pragma unroll
                for (int q = 0; q < 4; ++q) s += bf2f(qp[j][q] & 0xffffu) * bf2f(w[q] & 0xffffu) + bf2f(qp[j][q] >> 16) * bf2f(w[q] >> 16); }
            sc[kb] = valid ? s + bias : -1e30f;
        }
        float mx = sc[0];
#pragma unroll
        for (int kb = 1; kb < 6; ++kb) mx = fmaxf(mx, sc[kb]);
        mx = wave_max(mx);
        float sum = 0.f;
#pragma unroll
        for (int kb = 0; kb < 6; ++kb) { sc[kb] = __expf(sc[kb] - mx); sum += sc[kb]; }
        sum = wave_sum(sum); const float inv = 1.f / sum;
#pragma unroll
        for (int kb = 0; kb < 6; ++kb) pw[kb * 64 + c.lane] = sc[kb] * inv;
        asm volatile("s_waitcnt lgkmcnt(0)" ::: "memory");
        float o = 0.f;
        if (lat) {
            for (int i = 0; i < 128; ++i) { const int krow = b * SEQ + (rs + (i >> 4)) * 64 + cs + (i & 15); o += pw[i] * bf2f(P[(size_t)krow * INW + 1536 + h * 64 + c.lane]); }
        }
        for (int i = 0; i < 256; ++i) { const int krow = NLAT + b * CTXL + i; o += pw[128 + i] * bf2f(P[(size_t)krow * INW + 1536 + h * 64 + c.lane]); }
        br[(size_t)row * D + 768 + h * 64 + c.lane] = (bf16)f2bf(o);
        asm volatile("s_waitcnt lgkmcnt(0)" ::: "memory");
    }
}

__device__ __forceinline__ void phase_attn_mfma(const Ctx& c_in, int l, bool with_ctx_q) {
    LAUNDER(c_in);
    const Args& a = *c.a;
    const bf16* P = (const bf16*)(c.ws + WS_P); const bf16* VT2 = (const bf16*)(c.ws + WS_VT2); bf16* br = (bf16*)(c.ws + WS_BR);
    LAS float* rl = (LAS float*)c.lds;
    __syncthreads();
    for (int i = c.tid; i < 4 * 15 * 31; i += 512) rl[i] = a.in[I_RPB][(size_t)l * 4 * 15 * 31 + i];
    __syncthreads();
    const int nunits = 4096 + (with_ctx_q ? 256 : 0);
    const int q = c.lane & 15, fq = c.lane >> 4;
    for (int un = c.gw; un < nunits; un += c.NGW) {
        const bool lat = un < 4096;
        int h, b, qrow0, r = 0, c0 = 0, rs = 0, cw = 0;
        if (lat) { h = un & 3; const int j = (un >> 2) & 3; r = (un >> 4) & 63; b = un >> 10; c0 = 16 * j; cw = j == 0 ? 0 : (j == 1 ? 8 : (j == 2 ? 24 : 32));
                   rs = r - 4; rs = rs < 0 ? 0 : (rs > 56 ? 56 : rs); qrow0 = b * SEQ + r * 64 + c0; }
        else { const int v = un - 4096; h = v & 3; b = v >> 6; qrow0 = NLAT + b * CTXL + ((v >> 2) & 15) * 16; }
        bf16x8 qf[2];
#pragma unroll
        for (int kk = 0; kk < 2; ++kk) qf[kk] = *(const bf16x8*)(P + (size_t)(qrow0 + q) * INW + 1024 + h * 64 + 32 * kk + 8 * fq);
        f32x4 S[32];
        const int koff = 8 * (q >> 2) + (q & 3);
        const int ci = c0 + q; int cs = ci - 8; cs = cs < 0 ? 0 : (cs > 48 ? 48 : cs);
        if (lat) {
#pragma unroll
            for (int tb = 0; tb < 16; tb += 8) {
                bf16x8 kf[8][2];
#pragma unroll
                for (int u = 0; u < 8; ++u) { const int t = tb + u, blk = t >> 1, sOdd = t & 1;
                    const bf16* kp = P + (size_t)(b * SEQ + (rs + blk) * 64 + cw + koff + 4 * sOdd) * INW + 1280 + h * 64 + 8 * fq;
                    kf[u][0] = *(const bf16x8*)kp; kf[u][1] = *(const bf16x8*)(kp + 32); }
#pragma unroll
                for (int u = 0; u < 8; ++u) { const int t = tb + u, blk = t >> 1, sOdd = t & 1;
                    f32x4 acc = (f32x4){0.f, 0.f, 0.f, 0.f};
                    acc = __builtin_amdgcn_mfma_f32_16x16x32_bf16(kf[u][0], qf[0], acc, 0, 0, 0);
                    acc = __builtin_amdgcn_mfma_f32_16x16x32_bf16(kf[u][1], qf[1], acc, 0, 0, 0);
                    const LAS float* bp = rl + (h * 15 + (rs + blk - r + 7)) * 31 + 15 - ci;
#pragma unroll
                    for (int i = 0; i < 4; ++i) { const int kc = cw + 8 * fq + 4 * sOdd + i; const bool ok = kc >= cs && kc < cs + 16;
                        acc[i] = ok ? acc[i] + bp[ok ? kc : ci] : -1e30f; }
                    S[t] = acc; }
            }
        } else {
#pragma unroll
            for (int t = 0; t < 16; ++t) S[t] = (f32x4){-1e30f, -1e30f, -1e30f, -1e30f};
        }
#pragma unroll
        for (int tb = 16; tb < 32; tb += 8) {
            bf16x8 kf[8][2];
#pragma unroll
            for (int u = 0; u < 8; ++u) { const int t = tb + u, blk = (t >> 1) - 8, sOdd = t & 1;
                const bf16* kp = P + (size_t)(NLAT + b * CTXL + blk * 32 + koff + 4 * sOdd) * INW + 1280 + h * 64 + 8 * fq;
                kf[u][0] = *(const bf16x8*)kp; kf[u][1] = *(const bf16x8*)(kp + 32); }
#pragma unroll
            for (int u = 0; u < 8; ++u) { f32x4 acc = (f32x4){0.f, 0.f, 0.f, 0.f};
                acc = __builtin_amdgcn_mfma_f32_16x16x32_bf16(kf[u][0], qf[0], acc, 0, 0, 0);
                acc = __builtin_amdgcn_mfma_f32_16x16x32_bf16(kf[u][1], qf[1], acc, 0, 0, 0);
                S[tb + u] = acc; }
        }
        float mx = -1e30f;
#pragma unroll
        for (int t = 0; t < 32; ++t) mx = fmaxf(mx, fmaxf(fmaxf(S[t][0], S[t][1]), fmaxf(S[t][2], S[t][3])));
        mx = fmaxf(mx, SWZ_XOR(mx, 16));
        mx = fmaxf(mx, __builtin_bit_cast(float, __builtin_amdgcn_ds_bpermute((c.lane ^ 32) << 2, __builtin_bit_cast(int, mx))));
        float sum = 0.f;
#pragma unroll
        for (int t = 0; t < 32; ++t)
#pragma unroll
            for (int i = 0; i < 4; ++i) { const float e = __expf(S[t][i] - mx); S[t][i] = e; sum += e; }
        sum += SWZ_XOR(sum, 16);
        sum += __builtin_bit_cast(float, __builtin_amdgcn_ds_bpermute((c.lane ^ 32) << 2, __builtin_bit_cast(int, sum)));
        const float inv = __builtin_amdgcn_rcpf(sum);
        f32x4 O[4];
#pragma unroll
        for (int dt = 0; dt < 4; ++dt) O[dt] = (f32x4){0.f, 0.f, 0.f, 0.f};
#pragma unroll
        for (int bb = 0; bb < 16; bb += 4) {
            if (bb < 8 && !lat) continue;
            bf16x8 vb[4][4];
#pragma unroll
            for (int u = 0; u < 4; ++u) { const int blk = bb + u;
                const int tok0 = blk < 8 ? (b * SEQ + (rs + blk) * 64 + cw) : (NLAT + b * CTXL + (blk - 8) * 32);
#pragma unroll
                for (int dt = 0; dt < 4; ++dt) vb[u][dt] = *(const bf16x8*)(VT2 + (size_t)(h * 64 + 16 * dt + q) * MT + tok0 + 8 * fq); }
#pragma unroll
            for (int u = 0; u < 4; ++u) { const int blk = bb + u;
                u32x4 pw; pw.x = pk2(S[2 * blk][0] * inv, S[2 * blk][1] * inv); pw.y = pk2(S[2 * blk][2] * inv, S[2 * blk][3] * inv);
                pw.z = pk2(S[2 * blk + 1][0] * inv, S[2 * blk + 1][1] * inv); pw.w = pk2(S[2 * blk + 1][2] * inv, S[2 * blk + 1][3] * inv);
                const bf16x8 pa = __builtin_bit_cast(bf16x8, pw);
#pragma unroll
                for (int dt = 0; dt < 4; ++dt) O[dt] = __builtin_amdgcn_mfma_f32_16x16x32_bf16(pa, vb[u][dt], O[dt], 0, 0, 0); }
        }
#pragma unroll
        for (int dt = 0; dt < 4; ++dt)
#pragma unroll
            for (int i = 0; i < 4; ++i) br[(size_t)(qrow0 + 4 * fq + i) * D + 768 + h * 64 + 16 * dt + q] = (bf16)f2bf(O[dt][i]);
    }
    __syncthreads();
}
__device__ __forceinline__ void phase_attn_lds(const Ctx& c_in, int l, bool with_ctx_q) {
    LAUNDER(c_in);
    const Args& a = *c.a;
    const bf16* P = (const bf16*)(c.ws + WS_P); const bf16* VT2 = (const bf16*)(c.ws + WS_VT2); bf16* br = (bf16*)(c.ws + WS_BR);
    LAS float* rl = (LAS float*)c.lds;
    __syncthreads();
    for (int i = c.tid; i < 4 * 15 * 31; i += 512) rl[i] = a.in[I_RPB][(size_t)l * 4 * 15 * 31 + i];
    __syncthreads();
    const int q = c.lane & 15, fq = c.lane >> 4;
    const int bh = c.bid >> 4, sgrp = c.bid & 15, b = bh >> 2, h = bh & 3;
    LAS bf16* Kc = (LAS bf16*)(c.lds + 8192); LAS bf16* Vc = (LAS bf16*)(c.lds + 8192 + 36864);
    for (int i = c.tid; i < 256 * 8; i += 512) { const int key = i >> 3, pc = i & 7;
        *(LAS u32x4*)(Kc + key * 72 + pc * 8) = *(const u32x4*)(P + (size_t)(NLAT + b * CTXL + key) * INW + 1280 + h * 64 + pc * 8); }
    for (int i = c.tid; i < 64 * 32; i += 512) { const int d = i >> 5, pc = i & 31;
        *(LAS u32x4*)(Vc + d * 264 + pc * 8) = *(const u32x4*)(VT2 + (size_t)(h * 64 + d) * MT + NLAT + b * CTXL + pc * 8); }
    __syncthreads();
    for (int it = 0; it < 3; ++it) {
        const bool lat = it < 2;
        if (!lat && (!with_ctx_q || c.wid != 0)) break;
        int qrow0, r = 0, c0 = 0, rs = 0, cw = 0;
        if (lat) { const int u_ = (it * 16 + sgrp) * 8 + c.wid; const int j = u_ & 3; r = u_ >> 2; c0 = 16 * j; cw = j == 0 ? 0 : (j == 1 ? 8 : (j == 2 ? 24 : 32));
                   rs = r - 4; rs = rs < 0 ? 0 : (rs > 56 ? 56 : rs); qrow0 = b * SEQ + r * 64 + c0; }
        else qrow0 = NLAT + b * CTXL + sgrp * 16;
        bf16x8 qf[2];
#pragma unroll
        for (int kk = 0; kk < 2; ++kk) qf[kk] = *(const bf16x8*)(P + (size_t)(qrow0 + q) * INW + 1024 + h * 64 + 32 * kk + 8 * fq);
        f32x4 S[32];
        const int koff = 8 * (q >> 2) + (q & 3);
        const int ci = c0 + q; int cs = ci - 8; cs = cs < 0 ? 0 : (cs > 48 ? 48 : cs);
        if (lat) {
#pragma unroll
            for (int tb = 0; tb < 16; tb += 8) {
                bf16x8 kf[8][2];
#pragma unroll
                for (int u = 0; u < 8; ++u) { const int t = tb + u, blk = t >> 1, sOdd = t & 1;
                    const bf16* kp = P + (size_t)(b * SEQ + (rs + blk) * 64 + cw + koff + 4 * sOdd) * INW + 1280 + h * 64 + 8 * fq;
                    kf[u][0] = *(const bf16x8*)kp; kf[u][1] = *(const bf16x8*)(kp + 32); }
#pragma unroll
                for (int u = 0; u < 8; ++u) { const int t = tb + u, blk = t >> 1, sOdd = t & 1;
                    f32x4 acc = (f32x4){0.f, 0.f, 0.f, 0.f};
                    acc = __builtin_amdgcn_mfma_f32_16x16x32_bf16(kf[u][0], qf[0], acc, 0, 0, 0);
                    acc = __builtin_amdgcn_mfma_f32_16x16x32_bf16(kf[u][1], qf[1], acc, 0, 0, 0);
                    const LAS float* bp = rl + (h * 15 + (rs + blk - r + 7)) * 31 + 15 - ci;
#pragma unroll
                    for (int i = 0; i < 4; ++i) { const int kc = cw + 8 * fq + 4 * sOdd + i; const bool ok = kc >= cs && kc < cs + 16;
                        acc[i] = ok ? acc[i] + bp[ok ? kc : ci] : -1e30f; }
                    S[t] = acc; }
            }
        } else {
#pragma unroll
            for (int t = 0; t < 16; ++t) S[t] = (f32x4){-1e30f, -1e30f, -1e30f, -1e30f};
        }
#pragma unroll
        for (int tb = 16; tb < 32; tb += 8) {
            bf16x8 kf[8][2];
#pragma unroll
            for (int u = 0; u < 8; ++u) { const int t = tb + u, blk = (t >> 1) - 8, sOdd = t & 1;
                const LAS bf16* kp = Kc + (blk * 32 + koff + 4 * sOdd) * 72 + 8 * fq;
                kf[u][0] = *(const LAS bf16x8*)kp; kf[u][1] = *(const LAS bf16x8*)(kp + 32); }
#pragma unroll
            for (int u = 0; u < 8; ++u) { f32x4 acc = (f32x4){0.f, 0.f, 0.f, 0.f};
                acc = __builtin_amdgcn_mfma_f32_16x16x32_bf16(kf[u][0], qf[0], acc, 0, 0, 0);
                acc = __builtin_amdgcn_mfma_f32_16x16x32_bf16(kf[u][1], qf[1], acc, 0, 0, 0);
                S[tb + u] = acc; }
        }
        float mx = -1e30f;
#pragma unroll
        for (int t = 0; t < 32; ++t) mx = fmaxf(mx, fmaxf(fmaxf(S[t][0], S[t][1]), fmaxf(S[t][2], S[t][3])));
        mx = fmaxf(mx, SWZ_XOR(mx, 16));
        mx = fmaxf(mx, __builtin_bit_cast(float, __builtin_amdgcn_ds_bpermute((c.lane ^ 32) << 2, __builtin_bit_cast(int, mx))));
        float sum = 0.f;
#pragma unroll
        for (int t = 0; t < 32; ++t)
#pragma unroll
            for (int i = 0; i < 4; ++i) { const float e = __expf(S[t][i] - mx); S[t][i] = e; sum += e; }
        sum += SWZ_XOR(sum, 16);
        sum += __builtin_bit_cast(float, __builtin_amdgcn_ds_bpermute((c.lane ^ 32) << 2, __builtin_bit_cast(int, sum)));
        const float inv = __builtin_amdgcn_rcpf(sum);
        f32x4 O[4];
#pragma unroll
        for (int dt = 0; dt < 4; ++dt) O[dt] = (f32x4){0.f, 0.f, 0.f, 0.f};
#pragma unroll
        for (int bb = 0; bb < 16; bb += 4) {
            if (bb < 8 && !lat) continue;
            bf16x8 vb[4][4];
#pragma unroll
            for (int u = 0; u < 4; ++u) { const int blk = bb + u;
                if (blk < 8) { const int tok0 = b * SEQ + (rs + blk) * 64 + cw;
#pragma unroll
                    for (int dt = 0; dt < 4; ++dt) vb[u][dt] = *(const bf16x8*)(VT2 + (size_t)(h * 64 + 16 * dt + q) * MT + tok0 + 8 * fq); }
                else {
#pragma unroll
                    for (int dt = 0; dt < 4; ++dt) vb[u][dt] = *(const LAS bf16x8*)(Vc + (16 * dt + q) * 264 + (blk - 8) * 32 + 8 * fq); } }
#pragma unroll
            for (int u = 0; u < 4; ++u) { const int blk = bb + u;
                u32x4 pw; pw.x = pk2(S[2 * blk][0] * inv, S[2 * blk][1] * inv); pw.y = pk2(S[2 * blk][2] * inv, S[2 * blk][3] * inv);
                pw.z = pk2(S[2 * blk + 1][0] * inv, S[2 * blk + 1][1] * inv); pw.w = pk2(S[2 * blk + 1][2] * inv, S[2 * blk + 1][3] * inv);
                const bf16x8 pa = __builtin_bit_cast(bf16x8, pw);
#pragma unroll
                for (int dt = 0; dt < 4; ++dt) O[dt] = __builtin_amdgcn_mfma_f32_16x16x32_bf16(pa, vb[u][dt], O[dt], 0, 0, 0); }
        }
#pragma unroll
        for (int dt = 0; dt < 4; ++dt)
#pragma unroll
            for (int i = 0; i < 4; ++i) br[(size_t)(qrow0 + 4 * fq + i) * D + 768 + h * 64 + 16 * dt + q] = (bf16)f2bf(O[dt][i]);
    }
    __syncthreads();
}
__device__ __forceinline__ void phase_s5_carry(const Ctx& c_in, int l) {
    LAUNDER(c_in);
    if (c.gw >= 128) return;
    const int b = c.gw >> 5, g = (c.gw >> 1) & 15, dir = c.gw & 1, n = c.lane;
    const float* a16 = (const float*)(c.ws + WS_A16) + (((size_t)(l * 2 + dir) * 16 + g) * 64 + n) * 2;
    const float ar = a16[0], ai = a16[1];
    const float* sst = (const float*)(c.ws + WS_SST); bf16* ac = (bf16*)(c.ws + WS_ACAT);
    float hr = 0.f, hi = 0.f;
    for (int i0 = 0; i0 < 272; i0 += 16) {
        float sr[16], si[16]; int ao[16];
#pragma unroll
        for (int j = 0; j < 16; ++j) {
            const int i = i0 + j; int ch;
            if (dir == 0) ch = i < 16 ? (NLAT / 16 + b * 16 + i) : (b * 256 + (i - 16));
            else          ch = i < 16 ? (NLAT / 16 + b * 16 + (15 - i)) : (b * 256 + (255 - (i - 16)));
            const int so = (ch * 16 + g) * 256 + dir * 128 + n; ao[j] = (ch * 16 + g) * 512 + 256 + dir * 128 + n;
            sr[j] = sst[so]; si[j] = sst[so + 64];
        }
#pragma unroll
        for (int j = 0; j < 16; ++j) {
            ac[ao[j]] = (bf16)f2bf(hr); ac[ao[j] + 64] = (bf16)f2bf(hi);
            const float nr = ar * hr - ai * hi + sr[j], ni = ar * hi + ai * hr + si[j]; hr = nr; hi = ni;
        }
    }
}

__device__ __forceinline__ void phase_n2(const Ctx& c_in, int l) {
    LAUNDER(c_in);
    const Args& a = *c.a; unsigned char* ws = c.ws;
    const int nrows = (l == DEPTH - 1) ? NLAT : MT;
    LAS unsigned char* hb = c.lds + c.wid * N2_SLOT;
    LAS float* lgs = (LAS float*)(c.lds + LDS_MISC + 2048) + c.wid * 128;
    const u32x4* rwf = (const u32x4*)(ws + WS_RWF) + (size_t)l * 64 * 128;
    const float* rw = a.in[I_RW] + (size_t)l * D * NEXP; const float* rb = a.in[I_RB] + l * NEXP;
    unsigned* cnt = (unsigned*)(ws + WS_CTL) + CW_CNT + l * 32 * 64;
    LAS unsigned* lcnt = (LAS unsigned*)(c.lds + LDS_MISC + 1024);
    __syncthreads();
    if (c.tid < 64) lcnt[c.tid] = 0u;
    __syncthreads();
    u32x4 wf[4][2][2];
#pragma unroll
    for (int u = 0; u < 4; ++u)
#pragma unroll
        for (int nb = 0; nb < 2; ++nb)
#pragma unroll
            for (int p = 0; p < 2; ++p) wf[u][nb][p] = rwf[(size_t)(((c.wid * 4 + u) * 2 + nb) * 2 + p) * 64 + c.lane];
    for (int grp = c.gw; grp < nrows / 4; grp += c.NGW) {
        f32x4 yy[4][4], xx[4][4];
#pragma unroll
        for (int tk = 0; tk < 4; ++tk) { const int row = grp * 4 + tk; load_row_bf((const bf16*)(ws + WS_Y) + (size_t)row * D, c.lane, yy[tk]);
            if (l == 0) load_row(xin_row(a, row), c.lane, xx[tk]); else load_row_bf((const bf16*)(ws + WS_XS) + (size_t)row * D, c.lane, xx[tk]); }
#pragma unroll
        for (int tk = 0; tk < 4; ++tk) {
            const int row = grp * 4 + tk;
            f32x4 (&y)[4] = yy[tk]; f32x4 (&x)[4] = xx[tk];
            const float r = row_rms_scale(y);
            const float* gm = mod_ptr(ws, l, row, 2);
#pragma unroll
            for (int j = 0; j < 4; ++j) { const int o = 4 * c.lane + 256 * j; const f32x4 g = *(const f32x4*)(a.in[I_NMPOST] + l * D + o), m = *(const f32x4*)(gm + o);
                x[j] = x[j] + m * (y[j] * r * g); st_bf4((bf16*)(ws + WS_XS) + (size_t)row * D + o, x[j]); }
            norm_mod_split(x, a.in[I_NFPRE] + l * D, mod_ptr(ws, l, row, 3), mod_ptr(ws, l, row, 4), c.lane, hb + tk * N2_RS);
        }
        asm volatile("s_waitcnt lgkmcnt(0)" ::: "memory");
        const int e = c.lane & 31;
        u32x4 f8r[4];
#pragma unroll
        for (int tk = 0; tk < 4; ++tk) {
            const LAS u32x4* hp = (const LAS u32x4*)(hb + tk * N2_RS + 32 * c.lane); const LAS u32x4* lp = (const LAS u32x4*)(hb + N2_LO + tk * N2_RS + 32 * c.lane);
            const u32x4 a0 = hp[0], a1 = hp[1], b0 = lp[0], b1 = lp[1]; u32x4 f;
#define H2V(av, bv, q) (bf2f(av & 0xffffu) + bf2f(bv & 0xffffu)) * F8_X, (bf2f(av >> 16) + bf2f(bv >> 16)) * F8_X
            f.x = pk4_fp8(H2V(a0.x, b0.x, 0), H2V(a0.y, b0.y, 0)); f.y = pk4_fp8(H2V(a0.z, b0.z, 0), H2V(a0.w, b0.w, 0));
            f.z = pk4_fp8(H2V(a1.x, b1.x, 0), H2V(a1.y, b1.y, 0)); f.w = pk4_fp8(H2V(a1.z, b1.z, 0), H2V(a1.w, b1.w, 0));
#undef H2V
            f8r[tk] = f;
        }
        __syncthreads();
        {
            const int kq = c.lane >> 4;
            f32x4 acc[2][2];
#pragma unroll
            for (int tt = 0; tt < 2; ++tt)
#pragma unroll
                for (int nb = 0; nb < 2; ++nb) acc[tt][nb] = (f32x4){0.f, 0.f, 0.f, 0.f};
#pragma unroll
            for (int tt = 0; tt < 2; ++tt) {
                const int tok = 16 * tt + (c.lane & 15);
                const LAS unsigned char* ap = c.lds + (tok >> 2) * N2_SLOT + (tok & 3) * N2_RS + (c.wid * 4) * 64 + kq * 16;
#pragma unroll
                for (int u = 0; u < 4; ++u) {
                    const bf16x8 ah = *(const LAS bf16x8*)(ap + u * 64), al = *(const LAS bf16x8*)(ap + N2_LO + u * 64);
#pragma unroll
                    for (int nb = 0; nb < 2; ++nb) {
                        const bf16x8 wh = __builtin_bit_cast(bf16x8, wf[u][nb][0]), wl = __builtin_bit_cast(bf16x8, wf[u][nb][1]);
                        acc[tt][nb] = __builtin_amdgcn_mfma_f32_16x16x32_bf16(wh, ah, acc[tt][nb], 0, 0, 0);
                        acc[tt][nb] = __builtin_amdgcn_mfma_f32_16x16x32_bf16(wh, al, acc[tt][nb], 0, 0, 0);
                        acc[tt][nb] = __builtin_amdgcn_mfma_f32_16x16x32_bf16(wl, ah, acc[tt][nb], 0, 0, 0);
                    }
                }
            }
            asm volatile("s_waitcnt lgkmcnt(0)" ::: "memory");
            __syncthreads();
            LAS float* pp = (LAS float*)c.lds + c.wid * 1024;
#pragma unroll
            for (int tt = 0; tt < 2; ++tt)
#pragma unroll
                for (int nb = 0; nb < 2; ++nb) *(LAS f32x4*)(pp + (16 * tt + (c.lane & 15)) * 32 + 16 * nb + 4 * kq) = acc[tt][nb];
            asm volatile("s_waitcnt lgkmcnt(0)" ::: "memory");
            __syncthreads();
        }
        int myek = 0; float mywk = 0.f;
#pragma unroll
        for (int tk = 0; tk < 4; ++tk) {
            float v = rb[e];
#pragma unroll
            for (int w_ = 0; w_ < 8; ++w_) v += ((const LAS float*)c.lds)[w_ * 1024 + (4 * c.wid + tk) * 32 + e];
            float tv[4]; int ti[4];
#pragma unroll
            for (int k = 0; k < 4; ++k) {
                float bv = v; int bi = e;
#define ARGMAX_STEP(o) { const float ov = SWZ_XOR(bv, o); const int oi = SWZ_XOR_I(bi, o); if (ov > bv || (ov == bv && oi < bi)) { bv = ov; bi = oi; } }
                ARGMAX_STEP(1) ARGMAX_STEP(2) ARGMAX_STEP(4) ARGMAX_STEP(8) ARGMAX_STEP(16)
#undef ARGMAX_STEP
                tv[k] = bv; ti[k] = bi; if (e == bi) v = -3.0e38f;
            }
            const float e1 = __expf(tv[1] - tv[0]), e2 = __expf(tv[2] - tv[0]), e3 = __expf(tv[3] - tv[0]), inv = 1.f / (1.f + e1 + e2 + e3);
            const int k = c.lane & 3; const bool mine = (c.lane >> 2) == tk;
            const int ek = k == 0 ? ti[0] : (k == 1 ? ti[1] : (k == 2 ? ti[2] : ti[3]));
            const float wk = (k == 0 ? 1.f : (k == 1 ? e1 : (k == 2 ? e2 : e3))) * inv;
            myek = mine ? ek : myek; mywk = mine ? wk : mywk;
        }
        unsigned lidx = 0u;
        if (c.lane < 16) lidx = __hip_atomic_fetch_add(lcnt + myek, 1u, __ATOMIC_RELAXED, __HIP_MEMORY_SCOPE_WORKGROUP);
        __syncthreads();
        if (c.wid == 0 && c.lane < NEXP) { const unsigned n_ = lcnt[c.lane]; lcnt[32 + c.lane] = n_ ? atomicAdd(cnt + c.lane * 64, n_) : 0u; lcnt[c.lane] = 0u; }
        __syncthreads();
        int dst16 = 0;
        if (c.lane < 16) {
            const int idx = grp * 16 + c.lane;
            const unsigned slot = lcnt[32 + myek] + lidx;
            ((int*)(ws + WS_RE))[idx] = myek; ((int*)(ws + WS_RS))[idx] = (int)slot; ((float*)(ws + WS_RW))[idx] = mywk;
            dst16 = myek * MOE_CAP + (int)slot;
        }
#pragma unroll
        for (int tk = 0; tk < 4; ++tk) {
#pragma unroll
            for (int k = 0; k < 4; ++k) { const int dr = __builtin_amdgcn_readlane(dst16, 4 * tk + k);
                *(u32x4*)((unsigned char*)(ws + WS_XB) + (size_t)dr * D + 16 * c.lane) = f8r[tk]; }
        }
        asm volatile("s_waitcnt lgkmcnt(0)" ::: "memory");
    }
}

constexpr int LDS_TS = LDS_MISC + 1024;
__device__ __forceinline__ void moe_prefix(const Ctx& c_in, int l) {
    LAUNDER(c_in);
    LAS int* ts = (LAS int*)(c.lds + LDS_TS);
    unsigned* cnt = (unsigned*)(c.ws + WS_CTL) + CW_CNT + l * 32 * 64;
    __syncthreads();
    if (c.tid < NEXP) ts[64 + c.tid] = ((int)xb_ld(cnt + c.tid * 64) + 255) >> 8;
    __syncthreads();
    if (c.tid == 0) { int s_ = 0; for (int e = 0; e < NEXP; ++e) { ts[e] = s_; s_ += ts[64 + e]; } ts[32] = s_; }
    __syncthreads();
}
__device__ __forceinline__ void phase_comb(const Ctx& c_in, int l) {
    LAUNDER(c_in);
    const Args& a = *c.a; unsigned char* ws = c.ws;
    const bool last = (l == DEPTH - 1);
    const int nrows = last ? NLAT : MT;
    const bf16* YB = (const bf16*)(ws + WS_YB);
    const LAS int* ts = (const LAS int*)(c.lds + LDS_TS);
    for (int row0 = c.gw * 2; row0 < nrows; row0 += c.NGW * 2) {
        int dest[2][4]; float wk[2][4];
#pragma unroll
        for (int u = 0; u < 2; ++u)
#pragma unroll
            for (int k = 0; k < 4; ++k) { const int e_ = ((const int*)(ws + WS_RE))[(row0 + u) * 4 + k], sl = ((const int*)(ws + WS_RS))[(row0 + u) * 4 + k];
                dest[u][k] = ts[e_] * 256 + sl; wk[u][k] = ((const float*)(ws + WS_RW))[(row0 + u) * 4 + k]; }
        unsigned yb[2][4][4]; f32x4 xr[2][4];
#pragma unroll
        for (int u = 0; u < 2; ++u) {
#pragma unroll
            for (int k = 0; k < 4; ++k)
#pragma unroll
                for (int j = 0; j < 4; ++j) yb[u][k][j] = *(const unsigned*)((const unsigned char*)YB + (size_t)dest[u][k] * D + 4 * c.lane + 256 * j);
            load_row_bf((const bf16*)(ws + WS_XS) + (size_t)(row0 + u) * D, c.lane, xr[u]);
        }
#pragma unroll
        for (int u = 0; u < 2; ++u) {
            const int row = row0 + u;
            f32x4 y[4];
#pragma unroll
            for (int j = 0; j < 4; ++j) y[j] = (f32x4){0.f, 0.f, 0.f, 0.f};
#pragma unroll
            for (int k = 0; k < 4; ++k)
#pragma unroll
                for (int j = 0; j < 4; ++j) { const int v = (int)yb[u][k][j];
                    const f32x2 lo = __builtin_amdgcn_cvt_pk_f32_fp8(v, false), hi = __builtin_amdgcn_cvt_pk_f32_fp8(v, true);
                    y[j] += (f32x4){lo.x, lo.y, hi.x, hi.y} * (wk[u][k] * (1.f / F8_Y)); }
            f32x4 (&x)[4] = xr[u];
            const float r = row_rms_scale(y);
            const float* gf = mod_ptr(ws, l, row, 5);
#pragma unroll
            for (int j = 0; j < 4; ++j) { const int o = 4 * c.lane + 256 * j; const f32x4 g = *(const f32x4*)(a.in[I_NFPOST] + l * D + o), m = *(const f32x4*)(gf + o);
                x[j] = x[j] + m * (y[j] * r * g);
                if (last) *(f32x4*)(a.out + (size_t)row * D + o) = x[j]; else st_bf4((bf16*)(ws + WS_XS) + (size_t)row * D + o, x[j]); }
            if (!last) norm_mod_store<false, true, true>(x, a.in[I_NMPRE] + (l + 1) * D, mod_ptr(ws, l + 1, row, 0), mod_ptr(ws, l + 1, row, 1), (bf16*)(ws + WS_H) + (size_t)row * D, c.lane, nullptr, ws + WS_H8 + (size_t)row * D);
        }
    }
}

constexpr int NPHASE = 2 + 12 * DEPTH;
#ifndef ONLY_PH
#define ONLY_PH -1
#endif
#define PHASE(k, ...) if constexpr (ONLY_PH < 0 || (k) == ONLY_PH) if (args.ph_lo <= (k) && (k) < args.ph_hi) { __VA_ARGS__; if ((k) + 1 < args.ph_hi) xcd_barrier(bar); }
template <int L>
__device__ __forceinline__ void layer_phases(const Ctx& c, const Args& args, const XcdBarrier& bar) {
    constexpr int l = L, base = 2 + 12 * L;
    unsigned char* ws = c.ws;
    PHASE(base + 0, {
        const int nMf_ = (l == DEPTH - 1) ? NLAT / 256 : MT / 256, Uw_ = (MT / 256) * 7;
        EpiG1 E{ws, args.in[I_BBG] + (size_t)l * 4096, (const float*)(ws + WS_ROPE)};
        { SchedG1 S{(const char*)(ws + WS_H), (const char*)(ws + WS_WINT) + (size_t)l * NG1 * D * 2, MT / 256, nMf_, NG1 / 256, 7, c.G, c.bid, 0, Uw_};
          run_gemm(c.lds, ws + WS_END, pg8::Gemm{D, D, D}, S, E); __syncthreads(); }
        { SchedGate S{(const char*)(ws + WS_H8), (const char*)(ws + WS_WBG8) + (size_t)l * 4096 * D, nMf_, c.G, c.bid, Uw_ % c.G};
          run_gemm<EpiG1, SchedGate, true>(c.lds, ws + WS_END, pg8::Gemm{D / 2, D / 2, D / 2, F8_SC_W, F8_SC_X}, S, E); __syncthreads(); } })
    PHASE(base + 1, {
        SchedS5 S{(const char*)(ws + WS_ACAT), (const char*)(ws + WS_BT1) + (size_t)l * 16 * 256 * 256 * 2, 256, c.G, c.bid};
        EpiS1 E{(float*)(ws + WS_SST)};
        for (int r_ = 0; r_ < REP_S5; ++r_) { run_gemm(c.lds, ws + WS_END, pg8::Gemm{8192, 256, 256}, S, E); __syncthreads(); } })
    PHASE(base + 2, {
        phase_s5_carry(c, l);
        __syncthreads();
        { Ctx c2 = c; c2.brot = 16;
          for (int r_ = 0; r_ < REP_GLN; ++r_) phase_gmlp_ln(c2, l);
          for (int r_ = 0; r_ < REP_POOL; ++r_) phase_pool(c2, l);
          for (int r_ = 0; r_ < REP_ATT; ++r_) { if (c.G == 256) phase_attn_lds(c2, l, l != DEPTH - 1); else phase_attn_mfma(c2, l, l != DEPTH - 1); } } })
    PHASE(base + 3, {
#ifdef S5_NAIVE
        dbg_s5_readout(c, l);
#else
        { SchedS5 S{(const char*)(ws + WS_ACAT), (const char*)(ws + WS_BT3) + (size_t)l * 16 * 256 * 512 * 2, 512, c.G, c.bid};
          EpiS3 E{(bf16*)(ws + WS_YG)};
          for (int r_ = 0; r_ < REP_S5; ++r_) { run_gemm(c.lds, ws + WS_END, pg8::Gemm{8192, 512, 512}, S, E); __syncthreads(); } }
#endif
        __syncthreads();
        { SchedGM S{(const char*)(ws + WS_VT), (const char*)(ws + WS_WST) + (size_t)l * 4 * 256 * 128 * 2, c.G, c.G >= 216 ? c.bid - 80 : c.bid};
          EpiGM E{(const bf16*)(ws + WS_P), (bf16*)(ws + WS_BR), args.in[I_GBS] + (size_t)l * 512};
          for (int r_ = 0; r_ < REP_S5; ++r_) { run_gemm(c.lds, ws + WS_END, pg8::Gemm{128, 128, 128}, S, E); __syncthreads(); } } })
    PHASE(base + 4, {
        if (c.G >= 200 && c.bid >= 136) {
            const int nr_ = (l == DEPTH - 1) ? NLAT : MT;
            const int nw_ = (c.G - 136) * 8, w0_ = (c.bid - 136) * 8 + c.wid;
            for (int r0 = w0_ * 8; r0 < nr_; r0 += nw_ * 8) {
                u32x4 v[8];
                _Pragma("unroll")
                for (int u = 0; u < 8; ++u) v[u] = *(const u32x4*)((const bf16*)(ws + WS_BR) + (size_t)(r0 + u) * D + 512 + 8 * c.lane);
                _Pragma("unroll")
                for (int u = 0; u < 8; ++u) { u32x2 o;
                    o.x = pk4_fp8(bf2f(v[u].x & 0xffffu) * F8_B, bf2f(v[u].x >> 16) * F8_B, bf2f(v[u].y & 0xffffu) * F8_B, bf2f(v[u].y >> 16) * F8_B);
                    o.y = pk4_fp8(bf2f(v[u].z & 0xffffu) * F8_B, bf2f(v[u].z >> 16) * F8_B, bf2f(v[u].w & 0xffffu) * F8_B, bf2f(v[u].w >> 16) * F8_B);
                    *(u32x2*)(ws + WS_BR8 + (size_t)(r0 + u) * D + 512 + 8 * c.lane) = o; }
            }
        } else {
        PlainSched S{(const char*)(ws + WS_YG), (const char*)(ws + WS_WGLUT) + (size_t)l * 512 * 256 * 2, 256, 256, MT / 256, 2, c.G, c.bid};
        EpiGLU E{(bf16*)(ws + WS_BR8)};
        for (int r_ = 0; r_ < REP_S5; ++r_) { run_gemm(c.lds, ws + WS_END, pg8::Gemm{256, 256, 256}, S, E); __syncthreads(); } } })
    PHASE(base + 5, {
        for (int r_ = 0; r_ < REP_G2; ++r_) gemm_merge(c.lds, (const char*)(ws + WS_BR8), (const char*)(ws + WS_WBRT) + (size_t)l * 4 * D * 256, (const bf16*)(ws + WS_GATES), (bf16*)(ws + WS_MRG), (l == DEPTH - 1) ? NLAT / 256 : MT / 256, c.G, c.bid); })
    PHASE(base + 6, {
        PlainSched S{(const char*)(ws + WS_MRG), (const char*)(ws + WS_WOUTT) + (size_t)l * D * D * 2, D, D, (l == DEPTH - 1) ? NLAT / 256 : MT / 256, 4, c.G, c.bid};
        EpiBF E{(bf16*)(ws + WS_Y), D};
        for (int r_ = 0; r_ < REP_G3; ++r_) { run_gemm(c.lds, ws + WS_END, pg8::Gemm{D, D, D}, S, E); __syncthreads(); }
        if constexpr (DBG_G3 != 0) { run_gemm<decltype(E), decltype(S), false, DBG_G3>(c.lds, ws + WS_END, pg8::Gemm{D, D, D}, S, E); __syncthreads(); } })
    PHASE(base + 7, phase_n2(c, l))
    PHASE(base + 9, {
        moe_prefix(c, l);
        SchedMoE S{(const char*)(ws + WS_XB), (const char*)(ws + WS_W1T) + (size_t)l * NEXP * 2048 * D, (const LAS int*)(c.lds + LDS_TS), 8, c.G, c.bid, (size_t)2048 * D, true};
        EpiE1 E{(bf16*)(ws + WS_ACT), args.in[I_B1] + (size_t)l * NEXP * 2048}; constexpr int SCX = F8_SC_X;
        for (int r_ = 0; r_ < REP_MOE; ++r_) { run_gemm<decltype(E), decltype(S), true>(c.lds, ws + WS_END, pg8::Gemm{D / 2, D / 2, D / 2, F8_SC_W, SCX}, S, E); __syncthreads(); }
        if constexpr (DBG_MOE != 0) { run_gemm<decltype(E), decltype(S), true, DBG_MOE>(c.lds, ws + WS_END, pg8::Gemm{D / 2, D / 2, D / 2, F8_SC_W, SCX}, S, E); __syncthreads(); } })
    PHASE(base + 10, {
        if (N_LAUNCH_MODE == 0) moe_prefix(c, l);
        SchedMoE S{(const char*)(ws + WS_ACT), (const char*)(ws + WS_W2T) + (size_t)l * NEXP * D * D, (const LAS int*)(c.lds + LDS_TS), 4, c.G, c.bid, (size_t)D * D, false};
        EpiE2 E{(bf16*)(ws + WS_YB), args.in[I_B2] + (size_t)l * NEXP * D}; constexpr int SCX = F8_SC_ACT;
        for (int r_ = 0; r_ < REP_MOE; ++r_) { run_gemm<decltype(E), decltype(S), true>(c.lds, ws + WS_END, pg8::Gemm{D / 2, D / 2, D / 2, F8_SC_W, SCX}, S, E); __syncthreads(); }
        if constexpr (DBG_MOE != 0) { run_gemm<decltype(E), decltype(S), true, DBG_MOE>(c.lds, ws + WS_END, pg8::Gemm{D / 2, D / 2, D / 2, F8_SC_W, SCX}, S, E); __syncthreads(); } })
    PHASE(base + 11, { if (N_LAUNCH_MODE == 0) moe_prefix(c, l); phase_comb(c, l); })
}


__global__ void __launch_bounds__(512, 2) mega_fwd(Args args) {
    extern __shared__ __attribute__((aligned(16))) unsigned char lds_raw[];
    Ctx c; c.a = &args; c.ws = args.ws; c.lds = (LAS unsigned char*)lds_raw;
    c.tid = threadIdx.x; c.lane = c.tid & 63; c.wid = __builtin_amdgcn_readfirstlane(c.tid >> 6); c.brot = 0; c.G = gridDim.x; c.bid = blockIdx.x; c.gw = c.bid * 8 + c.wid; c.NGW = c.G * 8;
    unsigned char* ws = args.ws;
    volatile LAS unsigned* misc = (volatile LAS unsigned*)(c.lds + LDS_MISC);
    if (c.tid < 64) misc[c.tid] = 0u;
    __syncthreads();
    XcdBarrier bar; bar.bar = (unsigned*)(ws + WS_CTL) + CW_BAR; bar.x = 0; bar.st = misc + 8;
    const bool multi = (args.ph_hi - args.ph_lo) > 1;
    if (multi) bar = xcd_barrier_post((unsigned*)(ws + WS_CTL) + CW_BAR, misc + 8);

    PHASE(0, { for (int r_ = 0; r_ < REP_PREP; ++r_) { phase_prep(c); __syncthreads(); } })
    PHASE(1, phase_n1_layer0(c))
    layer_phases<0>(c, args, bar);
    layer_phases<1>(c, args, bar);
}

extern "C" void kernel_launch(void* const* d_in, const int* in_sizes, int n_in, void* d_out, int out_size, void* d_ws, size_t ws_size, hipStream_t stream) {
    static int grid = 0;
    if (grid == 0) {
        if (n_in != 37 || out_size != NLAT * D || ws_size < WS_END) { fprintf(stderr, "kernel_launch: unexpected shapes: n_in %d out %d ws %zu (need %zu)\n", n_in, out_size, ws_size, (size_t)WS_END); grid = -1; return; }
        int dev = 0, cus = 0;
        if (hipGetDevice(&dev) != hipSuccess || hipDeviceGetAttribute(&cus, hipDeviceAttributeMultiprocessorCount, dev) != hipSuccess) { grid = -1; return; }
        if (hipFuncSetAttribute((const void*)mega_fwd, hipFuncAttributeMaxDynamicSharedMemorySize, LDS_BYTES) != hipSuccess) { fprintf(stderr, "kernel_launch: hipFuncSetAttribute failed\n"); grid = -1; return; }
        int per_cu = 0;
        if (hipOccupancyMaxActiveBlocksPerMultiprocessor(&per_cu, (const void*)mega_fwd, 512, LDS_BYTES) != hipSuccess || per_cu < 1) fprintf(stderr, "kernel_launch: occupancy query says %d blocks/CU\n", per_cu);
        (void)hipGetLastError();
        grid = cus;
    }
    if (grid < 0) return;
    (void)hipMemsetAsync((char*)d_ws + WS_CTL, 0, CTL_BYTES, stream);
    Args a{};
    for (int i = 0; i < 37; ++i) a.in[i] = (const float*)d_in[i];
    a.out = (float*)d_out; a.ws = (unsigned char*)d_ws;
#if N_LAUNCH_MODE
    a.ph_lo = 0; a.ph_hi = NPHASE;
    hipLaunchKernelGGL(mega_fwd, dim3(grid), dim3(512), LDS_BYTES, stream, a);
#else
    for (int ph = 0; ph < NPHASE; ++ph) { a.ph_lo = ph; a.ph_hi = ph + 1; hipLaunchKernelGGL(mega_fwd, dim3(grid), dim3(512), LDS_BYTES, stream, a); }
#endif
}
```

```cpp
#include <hip/hip_runtime.h>
#include <cstdio>
#include <cstdint>


#ifndef N_LAUNCH_MODE
#define N_LAUNCH_MODE 1
#endif
#ifndef USE_ENGINE
#define USE_ENGINE 1
#endif


#ifndef REP_PREP
#define REP_PREP 1
#endif
#ifndef REP_GLN
#define REP_GLN 1
#endif
#ifndef REP_POOL
#define REP_POOL 1
#endif
#ifndef REP_ATT
#define REP_ATT 1
#endif
#ifndef REP_MIX
#define REP_MIX 1
#endif
#ifndef REP_G1
#define REP_G1 1
#endif
#ifndef REP_MOE
#define REP_MOE 1
#endif
#ifndef REP_G2
#define REP_G2 1
#endif
#ifndef REP_G3
#define REP_G3 1
#endif
#ifndef REP_S5
#define REP_S5 1
#endif
#ifndef DBG_MOE
#define DBG_MOE 0
#endif
#ifndef DBG_G3
#define DBG_G3 0
#endif
typedef unsigned short bf16;
typedef float f32x4 __attribute__((ext_vector_type(4)));
typedef float f32x2 __attribute__((ext_vector_type(2)));
typedef short bf16x8 __attribute__((ext_vector_type(8)));
typedef unsigned u32x4 __attribute__((ext_vector_type(4)));
typedef unsigned u32x2 __attribute__((ext_vector_type(2)));
#define LAS __attribute__((address_space(3)))

constexpr int D = 1024, NBATCH = 4, SEQ = 4096, CTXL = 256, DEPTH = 2;
constexpr int NLAT = NBATCH * SEQ, NCTX = NBATCH * CTXL, MT = NLAT + NCTX;
constexpr int INW = 1792, NG1 = INW + 4096;
constexpr int NEXP = 32, DEXP = 1024;
constexpr int NCHUNK = MT / 16, NCHUNK_PAD = 1280;
constexpr int XB_ROWS = 78080;
constexpr float EPS = 1e-6f;
constexpr float F8_W = 64.f, F8_X = 8.f, F8_ACT = 4.f, F8_Y = 8.f, F8_B = 8.f, F8_G = 255.f;
constexpr int MOE_CAP = 17408;
constexpr int F8_SC_W = 0x79797979, F8_SC_X = 0x7c7c7c7c, F8_SC_ACT = 0x7d7d7d7d;

constexpr size_t al256(size_t x) { return (x + 255) & ~(size_t)255; }
constexpr size_t WS_CTL = 0, CTL_BYTES = 1u << 20;
constexpr size_t WS_MODS = WS_CTL + CTL_BYTES;
constexpr size_t WS_ROPE = WS_MODS + al256((size_t)DEPTH * 5 * 6144 * 4);
constexpr size_t WS_A16 = WS_ROPE + al256(65 * 16 * 2 * 4);
constexpr size_t WS_WINT = WS_A16 + al256((size_t)DEPTH * 2 * 16 * 64 * 2 * 4);
constexpr size_t WS_WBRT = WS_WINT + al256((size_t)DEPTH * NG1 * D * 2);
constexpr size_t WS_WOUTT = WS_WBRT + al256((size_t)DEPTH * 4 * D * 256 * 2);
constexpr size_t WS_WGLUT = WS_WOUTT + al256((size_t)DEPTH * D * D * 2);
constexpr size_t WS_WST = WS_WGLUT + al256((size_t)DEPTH * 512 * 256 * 2);
constexpr size_t WS_BT1 = WS_WST + al256((size_t)DEPTH * 4 * 256 * 128 * 2);
constexpr size_t WS_BT3 = WS_BT1 + al256((size_t)DEPTH * 16 * 256 * 256 * 2);
constexpr size_t WS_W1T = WS_BT3 + al256((size_t)DEPTH * 16 * 256 * 512 * 2);
constexpr size_t WS_W2T = WS_W1T + al256((size_t)DEPTH * NEXP * 2048 * D);
constexpr size_t WS_XS = WS_W2T + al256((size_t)DEPTH * NEXP * D * D);
constexpr size_t WS_H = WS_XS + al256((size_t)MT * D * 4);
constexpr size_t WS_P = WS_H + al256((size_t)MT * D * 2);
constexpr size_t WS_GATES = WS_P + al256((size_t)MT * INW * 2);
constexpr size_t WS_ACAT = WS_GATES + al256((size_t)MT * 4096 * 2);
constexpr size_t WS_SST = WS_ACAT + al256((size_t)NCHUNK_PAD * 16 * 512 * 2);
constexpr size_t WS_VT = WS_SST + al256((size_t)NCHUNK_PAD * 16 * 256 * 4);
constexpr size_t WS_YG = WS_VT + al256((size_t)4 * 8704 * 128 * 2);
constexpr size_t WS_BR = WS_YG + al256((size_t)MT * 256 * 2);
constexpr size_t WS_MRGF = WS_BR + al256((size_t)MT * D * 2);
constexpr size_t WS_MRG = WS_MRGF + 256;
constexpr size_t WS_Y = WS_MRG + al256((size_t)MT * D * 2);
constexpr size_t WS_RE = WS_Y + al256((size_t)MT * D * 4);
constexpr size_t WS_RS = WS_RE + al256((size_t)MT * 16);
constexpr size_t WS_RW = WS_RS + al256((size_t)MT * 16);
constexpr size_t WS_TILE = WS_RW + al256((size_t)MT * 16);
constexpr size_t WS_XB = WS_TILE + 4096;
constexpr size_t WS_ACT = WS_XB + al256((size_t)NEXP * MOE_CAP * D);
constexpr size_t WS_YB = WS_ACT + al256((size_t)XB_ROWS * D);
constexpr size_t WS_VT2 = WS_YB + al256((size_t)XB_ROWS * D * 2);
constexpr size_t WS_RWF = WS_VT2 + al256((size_t)256 * MT * 2);
constexpr size_t WS_WBG8 = WS_RWF + al256((size_t)DEPTH * 32 * 2 * 2 * 64 * 16);
constexpr size_t WS_H8 = WS_WBG8 + al256((size_t)DEPTH * 4096 * D);
constexpr size_t WS_BR8 = WS_H8 + al256((size_t)MT * D);
constexpr size_t WS_END = WS_BR8 + al256((size_t)MT * D);
constexpr int CW_BAR = 4096;
constexpr int CW_CNT = 16384;

constexpr int LDS_STAGE = 131072, LDS_MISC = 133120, LDS_BYTES = 147456;

__device__ __forceinline__ float bf2f(unsigned v) { return __uint_as_float(v << 16); }
__device__ __forceinline__ unsigned f2bf(float f) { unsigned u = __float_as_uint(f); return (u + 0x7fffu + ((u >> 16) & 1u)) >> 16; }
__device__ __forceinline__ unsigned pk2(float lo, float hi) { unsigned r; asm volatile("v_cvt_pk_bf16_f32 %0, %1, %2" : "=v"(r) : "v"(lo), "v"(hi)); return r; }
#define SWZ_XOR(v, o) __builtin_bit_cast(float, __builtin_amdgcn_ds_swizzle(__builtin_bit_cast(int, (v)), ((o) << 10) | 0x1f))
#define SWZ_XOR_I(v, o) __builtin_amdgcn_ds_swizzle((v), ((o) << 10) | 0x1f)
__device__ __forceinline__ float wave_sum(float v) {
    v += SWZ_XOR(v, 1); v += SWZ_XOR(v, 2); v += SWZ_XOR(v, 4); v += SWZ_XOR(v, 8); v += SWZ_XOR(v, 16);
    return __builtin_bit_cast(float, __builtin_amdgcn_readlane(__builtin_bit_cast(int, v), 0)) + __builtin_bit_cast(float, __builtin_amdgcn_readlane(__builtin_bit_cast(int, v), 32));
}
__device__ __forceinline__ unsigned pk4_fp8(float a, float b, float c, float d) {
    a = fminf(fmaxf(a, -448.f), 448.f); b = fminf(fmaxf(b, -448.f), 448.f); c = fminf(fmaxf(c, -448.f), 448.f); d = fminf(fmaxf(d, -448.f), 448.f);
    int p = __builtin_amdgcn_cvt_pk_fp8_f32(a, b, 0, false); p = __builtin_amdgcn_cvt_pk_fp8_f32(c, d, p, true); return (unsigned)p;
}
__device__ __forceinline__ unsigned pk4_fp8_nc(float a, float b, float c, float d) {
    int p = __builtin_amdgcn_cvt_pk_fp8_f32(a, b, 0, false); p = __builtin_amdgcn_cvt_pk_fp8_f32(c, d, p, true); return (unsigned)p;
}
__device__ __forceinline__ unsigned pk4_u8(float a, float b, float c, float d) {
    unsigned r = __builtin_amdgcn_cvt_pk_u8_f32(a, 0, 0u); r = __builtin_amdgcn_cvt_pk_u8_f32(b, 1, r); r = __builtin_amdgcn_cvt_pk_u8_f32(c, 2, r); return __builtin_amdgcn_cvt_pk_u8_f32(d, 3, r);
}
__device__ __forceinline__ unsigned char f8_1(float v) { v = fminf(fmaxf(v, -448.f), 448.f); return (unsigned char)(__builtin_amdgcn_cvt_pk_fp8_f32(v, v, 0, false) & 0xff); }
__device__ __forceinline__ float wave_max(float v) {
    v = fmaxf(v, SWZ_XOR(v, 1)); v = fmaxf(v, SWZ_XOR(v, 2)); v = fmaxf(v, SWZ_XOR(v, 4)); v = fmaxf(v, SWZ_XOR(v, 8)); v = fmaxf(v, SWZ_XOR(v, 16));
    return fmaxf(__builtin_bit_cast(float, __builtin_amdgcn_readlane(__builtin_bit_cast(int, v), 0)), __builtin_bit_cast(float, __builtin_amdgcn_readlane(__builtin_bit_cast(int, v), 32)));
}
__device__ __forceinline__ float sigmoidf_(float x) { return __builtin_amdgcn_rcpf(1.f + __expf(-x)); }
__device__ __forceinline__ float sigmoid_g(float x) { return __builtin_amdgcn_rcpf(__builtin_fmaf(__builtin_amdgcn_exp2f(x * -1.4426950408889634f), 1.f / F8_G, 1.f / F8_G)); }
__device__ __forceinline__ float gelu_tanh(float x) {
    const float w = x * (-2.f * 0.7978845608028654f * 1.4426950408889634f - (2.f * 0.7978845608028654f * 0.044715f * 1.4426950408889634f) * (x * x));
    return x * __builtin_amdgcn_rcpf(1.f + __builtin_amdgcn_exp2f(w));
}

#define XB_TMO      128
#define XB_XCNT(j)  (256  + 64 * (j))
#define XB_XSUB(j)  (1280 + 64 * (j))
#define XB_XGEN(j)  (2304 + 64 * (j))
#define XB_TOP      3328
#define XB_TOPGEN   3392
#define XCD_BAR_WORDS 3456
#define XB_SPIN_CAP (1u << 22)
__device__ __forceinline__ unsigned xb_ld(unsigned* p)              { return __hip_atomic_load(p, __ATOMIC_RELAXED, __HIP_MEMORY_SCOPE_AGENT); }
__device__ __forceinline__ unsigned xb_add(unsigned* p, unsigned v) { return __hip_atomic_fetch_add(p, v, __ATOMIC_RELAXED, __HIP_MEMORY_SCOPE_AGENT); }
__device__ __forceinline__ unsigned xb_xcc_id() { return (unsigned)__builtin_amdgcn_s_getreg((3 << 11) | 20) & 0xFu; }
#define XB_SPIN(cond, bar) do { unsigned _sp = 0; while (cond) { __builtin_amdgcn_s_sleep(1); \
    if ((++_sp & 255u) == 0u) { if (xb_ld(&(bar)[XB_TMO])) break; if (_sp > XB_SPIN_CAP) { atomicAdd(&(bar)[XB_TMO], 1u); break; } } } } while (0)
struct XcdBarrier { unsigned* bar; unsigned x; volatile LAS unsigned* st; };
__device__ __forceinline__ XcdBarrier xcd_barrier_post(unsigned* bar, volatile LAS unsigned* st) {
    XcdBarrier b; b.bar = bar; b.x = xb_xcc_id(); b.st = st;
    if (threadIdx.x == 0) (void)xb_add(&bar[XB_XCNT(b.x)], 1u);
    return b;
}
__device__ __forceinline__ void xcd_barrier_complete(unsigned* bar, unsigned x, unsigned& nloc, unsigned& nx) {
    const unsigned G = gridDim.x * gridDim.y * gridDim.z;
    unsigned sum, cnt, mine, sp = 0u;
    for (;;) {
        sum = 0u; cnt = 0u; mine = 0u;
#pragma unroll
        for (unsigned j = 0; j < 16; ++j) { const unsigned c = xb_ld(&bar[XB_XCNT(j)]); sum += c; cnt += (c > 0u) ? 1u : 0u; mine = (j == x) ? c : mine; }
        if (sum == G) break;
        __builtin_amdgcn_s_sleep(1);
        if ((++sp & 255u) == 0u) { if (xb_ld(&bar[XB_TMO])) break; if (sp > XB_SPIN_CAP) { atomicAdd(&bar[XB_TMO], 1u); break; } }
    }
    nloc = mine > 0u ? mine : 1u; nx = cnt > 0u ? cnt : 1u;
}
__device__ __forceinline__ void xcd_barrier(const XcdBarrier& b) {
    asm volatile("s_waitcnt vmcnt(0)" ::: "memory");
    __syncthreads();
    if (threadIdx.x == 0) {
        unsigned* bar = b.bar;
        __builtin_amdgcn_s_waitcnt(0);
        unsigned nloc = b.st[0], nx = b.st[1];
        if (nloc == 0u) { xcd_barrier_complete(bar, b.x, nloc, nx); b.st[0] = nloc; b.st[1] = nx; }
        const unsigned old = xb_add(&bar[XB_XSUB(b.x)], 1u);
        const unsigned gen = old / nloc;
        if (old + 1u == (gen + 1u) * nloc) {
            __builtin_amdgcn_fence(__ATOMIC_RELEASE, "agent");
            asm volatile("s_waitcnt vmcnt(0)" ::: "memory");
            const unsigned og = xb_add(&bar[XB_TOP], 1u);
            const unsigned tg = og / nx;
            if (og + 1u == (tg + 1u) * nx) xb_add(&bar[XB_TOPGEN], 1u);
            else XB_SPIN(xb_ld(&bar[XB_TOPGEN]) == tg, bar);
            __builtin_amdgcn_fence(__ATOMIC_ACQUIRE, "agent");
            xb_add(&bar[XB_XGEN(b.x)], 1u);
            asm volatile("s_waitcnt vmcnt(0)" ::: "memory");
        } else {
            XB_SPIN(xb_ld(&bar[XB_XGEN(b.x)]) == gen, bar);
            __builtin_amdgcn_fence(__ATOMIC_ACQUIRE, "agent");
            asm volatile("s_waitcnt vmcnt(0)" ::: "memory");
        }
    }
    __syncthreads();
}

__device__ __forceinline__ const char* uptr(const char* p) {
    const unsigned long long v = (unsigned long long)p;
    const unsigned lo = __builtin_amdgcn_readfirstlane((unsigned)v), hi = __builtin_amdgcn_readfirstlane((unsigned)(v >> 32));
    return (const char*)(((unsigned long long)hi << 32) | lo);
}
struct EpiNoPre {};
template <class Epi, bool ON> struct EpiPreOf { typedef EpiNoPre type; };
template <class Epi> struct EpiPreOf<Epi, true> { typedef typename Epi::Pre type; };
namespace pg8 {
constexpr int BM = 256, BK = 64, HALF = 128, HTB = HALF * BK * 2, STAGE_BYTES = 8 * HTB, NXCD = 8, WGM = 8;
__host__ __device__ __forceinline__ int lds_byte(int r, int c) { const int st = (r >> 4) * 2 + (c >> 5), rr = r & 15, cc = c & 31, ob = rr * 64 + cc * 2; return st * 1024 + (ob ^ (((ob >> 9) & 1) << 5)); }
__host__ __device__ __forceinline__ void stage_rc(int b, int& R, int& C) { const int st = b / 1024, sb = b % 1024, swz = sb ^ (((sb >> 9) & 1) << 5); R = (st >> 1) * 16 + swz / 64; C = (st & 1) * 32 + (swz % 64) / 2; }

struct Unit { int pm, pn, aux; const char* a; const char* b; };
struct Gemm { int lda, ldb, K; int sc_w = 0x7f7f7f7f, sc_x = 0x7f7f7f7f; };

__device__ __forceinline__ bool plain_order(int L, int nM, int nN, int& pm, int& pn) {
    const int nwg = nM * nN; if (L >= nwg) return false;
    int wgid = L; { const int q = nwg / NXCD, r = nwg % NXCD, xcd = wgid % NXCD, off = wgid / NXCD; wgid = (xcd < r ? xcd * (q + 1) : r * (q + 1) + (xcd - r) * q) + off; }
    const int nig = WGM * nN, gid = wgid / nig, fm = gid * WGM, gsz = (nM - fm) < WGM ? (nM - fm) : WGM;
    pm = fm + ((wgid % nig) % gsz); pn = (wgid % nig) / gsz; return true;
}

typedef int v8i32 __attribute__((ext_vector_type(8)));
__device__ __forceinline__ v8i32 cat8(bf16x8 lo, bf16x8 hi) { const u32x4 a = __builtin_bit_cast(u32x4, lo), b = __builtin_bit_cast(u32x4, hi);
    return (v8i32){(int)a.x, (int)a.y, (int)a.z, (int)a.w, (int)b.x, (int)b.y, (int)b.z, (int)b.w}; }
template <class Epi, class Sched, bool FP8 = false, int DBG = 0, bool PEEL = false>
__device__ __forceinline__ void gemm_phase(LAS unsigned char* lds, const Gemm g, const Sched& S, const Epi& E) {
    int tid_ = threadIdx.x; asm volatile("" : "+v"(tid_));
    const int tid = tid_, wid = __builtin_amdgcn_readfirstlane(tid >> 6), lane = tid & 63, wr = wid >> 2, wc = wid & 3, fr = lane & 15, fq = lane >> 4;
    const int K = g.K, nt = K / BK;
    unsigned voffA[2], voffB[2];
#pragma unroll
    for (int i = 0; i < 2; ++i) { int R, C; stage_rc(tid * 16 + i * 8192, R, C);
        voffA[i] = (unsigned)(R * g.lda + C) * 2u; voffB[i] = (unsigned)(R * g.ldb + C) * 2u; }
    const size_t kstep = (size_t)(BK * 2);
    const size_t hstepA = (size_t)HALF * g.lda * 2, hstepB = (size_t)HALF * g.ldb * 2;
    const unsigned ldsw = (unsigned)wid * 1024u;
    const int aoff = lds_byte(wr * 64 + fr, fq * 8), boff = lds_byte(wc * 32 + fr, fq * 8);
#define PG8_SA(b, h) (((b) * 2 + (h)) * HTB)
#define PG8_SB(b, h) ((4 + (b) * 2 + (h)) * HTB)
#define PG8_STAGE(bufoff, gbase, voff) do { if constexpr (!(DBG & 4)) { _Pragma("unroll") for (int _i = 0; _i < 2; ++_i) \
        __builtin_amdgcn_global_load_lds((const unsigned*)((const char*)(gbase) + (voff)[_i]), (LAS unsigned*)(lds + (bufoff) + ldsw + _i * 8192), 16, 0, 0); } } while (0)
#define PG8_LD8(p_) ({ const u32x4 lo_ = *(const LAS u32x4*)(p_), hi_ = *(const LAS u32x4*)((p_) + 1024); (v8i32){(int)lo_.x, (int)lo_.y, (int)lo_.z, (int)lo_.w, (int)hi_.x, (int)hi_.y, (int)hi_.z, (int)hi_.w}; })
#define PG8_LDA(dst, b, h) do { if constexpr (!(DBG & 8)) { _Pragma("unroll") for (int m = 0; m < 4; ++m) dst[m] = PG8_LD8(lds + PG8_SA(b, h) + aoff + m * 2048); } } while (0)
#define PG8_LDB(dst, b, h) do { if constexpr (!(DBG & 8)) { _Pragma("unroll") for (int n = 0; n < 2; ++n) dst[n] = PG8_LD8(lds + PG8_SB(b, h) + boff + n * 2048); } } while (0)
#define PG8_LO(v_) __builtin_bit_cast(bf16x8, __builtin_shufflevector(v_, v_, 0, 1, 2, 3))
#define PG8_HI(v_) __builtin_bit_cast(bf16x8, __builtin_shufflevector(v_, v_, 4, 5, 6, 7))
#define PG8_MMA(ai, bj, At, Bt) do { __builtin_amdgcn_s_setprio(1); _Pragma("unroll") for (int m = 0; m < 4; ++m) _Pragma("unroll") for (int n = 0; n < 2; ++n) { \
        if constexpr (DBG & 2) asm volatile("" :: "v"(Bt[n]), "v"(At[m])); \
        else if constexpr (FP8) asm volatile("s_nop 1\n\tv_mfma_f32_16x16x128_f8f6f4 %0, %1, %2, %0" : "+v"(acc[ai][bj][m][n]) : "v"(Bt[n]), "v"(At[m]));   \
        else { acc[ai][bj][m][n] = __builtin_amdgcn_mfma_f32_16x16x32_bf16(PG8_LO(Bt[n]), PG8_LO(At[m]), acc[ai][bj][m][n], 0, 0, 0); \
               acc[ai][bj][m][n] = __builtin_amdgcn_mfma_f32_16x16x32_bf16(PG8_HI(Bt[n]), PG8_HI(At[m]), acc[ai][bj][m][n], 0, 0, 0); } } \
        __builtin_amdgcn_s_setprio(0); } while (0)
#define PG8_WAIT_V(n) asm volatile("s_waitcnt vmcnt(" #n ")" ::: "memory")
#define PG8_WAIT_L(n) asm volatile("s_waitcnt lgkmcnt(" #n ")" ::: "memory")
#define PG8_BAR __builtin_amdgcn_s_barrier()
#define PG8_SCHED __builtin_amdgcn_sched_barrier(0)
    Unit cur, nxt; int ui = 0;
    if (!S.next(0, cur)) return;
    f32x4 acc[2][2][4][2];
#pragma unroll
    for (int a = 0; a < 2; ++a)
#pragma unroll
        for (int b = 0; b < 2; ++b)
#pragma unroll
            for (int m = 0; m < 4; ++m)
#pragma unroll
                for (int n = 0; n < 2; ++n) acc[a][b][m][n] = (f32x4){0.f, 0.f, 0.f, 0.f};
    v8i32 At[4] = {}, B0[2] = {}, B1[2] = {};
    const int sc_w_ = g.sc_w, sc_x_ = g.sc_x;
    const char* cA = uptr(cur.a); const char* cB = uptr(cur.b);
    PG8_STAGE(PG8_SB(0, 0), cB, voffB); PG8_STAGE(PG8_SB(0, 1), cB + hstepB, voffB); PG8_STAGE(PG8_SA(0, 0), cA, voffA); PG8_STAGE(PG8_SA(0, 1), cA + hstepA, voffA);
    if (wr == 1) PG8_BAR;
    PG8_WAIT_V(2); PG8_BAR;
    PG8_STAGE(PG8_SB(1, 0), cB + kstep, voffB); PG8_STAGE(PG8_SA(1, 0), cA + kstep, voffA); PG8_STAGE(PG8_SB(1, 1), cB + hstepB + kstep, voffB);
    PG8_WAIT_V(6); PG8_BAR;
    for (;;) {
        const bool has_next = S.next(ui + 1, nxt);
        const char* nA = has_next ? uptr(nxt.a) : cA; const char* nB = has_next ? uptr(nxt.b) : cB;
#define PG8_KBODY(W12) { \
            const bool last = (t == nt - 2); \
            const char* a1 = cA + (size_t)(t + 1) * kstep; \
            const char* a2 = last ? nA : cA + (size_t)(t + 2) * kstep; const char* b2 = last ? nB : cB + (size_t)(t + 2) * kstep; \
            const char* a3 = a2 + kstep; const char* b3 = b2 + kstep; \
            asm volatile("" : "+s"(a1), "+s"(a2), "+s"(a3), "+s"(b2), "+s"(b3));     \
            PG8_LDB(B0, 0, 0); PG8_LDB(B1, 0, 1); PG8_SCHED; PG8_LDA(At, 0, 0); PG8_STAGE(PG8_SA(1, 1), a1 + hstepA, voffA); \
            W12; PG8_WAIT_L(0); PG8_BAR; PG8_MMA(0, 0, At, B0); PG8_MMA(0, 1, At, B1); PG8_BAR; PG8_SCHED; \
            PG8_LDA(At, 0, 1); PG8_STAGE(PG8_SB(0, 0), b2, voffB); PG8_STAGE(PG8_SB(0, 1), b2 + hstepB, voffB); PG8_STAGE(PG8_SA(0, 0), a2, voffA); \
            W12; PG8_WAIT_L(0); PG8_BAR; PG8_MMA(1, 0, At, B0); PG8_MMA(1, 1, At, B1); PG8_BAR; PG8_SCHED; \
            PG8_LDB(B0, 1, 0); PG8_LDB(B1, 1, 1); PG8_SCHED; PG8_LDA(At, 1, 0); PG8_STAGE(PG8_SA(0, 1), a2 + hstepA, voffA); \
            PG8_WAIT_V(8); PG8_WAIT_L(0); PG8_BAR; PG8_MMA(0, 0, At, B0); PG8_MMA(0, 1, At, B1); PG8_BAR; PG8_SCHED; \
            PG8_LDA(At, 1, 1); PG8_STAGE(PG8_SB(1, 0), b3, voffB); PG8_STAGE(PG8_SB(1, 1), b3 + hstepB, voffB); PG8_STAGE(PG8_SA(1, 0), a3, voffA); \
            PG8_WAIT_V(8); PG8_WAIT_L(0); PG8_BAR; PG8_MMA(1, 0, At, B0); PG8_MMA(1, 1, At, B1); PG8_BAR; PG8_SCHED; }
        int t = 0;
        if constexpr (PEEL) { if (ui > 0) { PG8_KBODY((void)0) t = 2; } }
        for (; t < nt; t += 2) PG8_KBODY(PG8_WAIT_V(8))
#undef PG8_KBODY
        typename EpiPreOf<Epi, PEEL>::type pre_;
        if constexpr (PEEL) { int pfq = fq; asm volatile("" : "+v"(pfq)); E.pre(cur, wc, pfq, pre_); }
        if constexpr (PEEL) PG8_WAIT_V(0);
        if constexpr (FP8) { asm volatile("s_nop 15\n\ts_nop 15" ::: "memory");
            _Pragma("unroll") for (int a = 0; a < 2; ++a) _Pragma("unroll") for (int b = 0; b < 2; ++b) _Pragma("unroll") for (int m = 0; m < 4; ++m) _Pragma("unroll") for (int n = 0; n < 2; ++n)
                asm volatile("" : "+v"(acc[a][b][m][n])); }
        if (wr == 0) PG8_BAR;
        { int efr = fr, efq = fq; asm volatile("" : "+v"(efr), "+v"(efq));
          if constexpr (!(DBG & 1)) { if constexpr (PEEL) E(acc, cur, wr, wc, efr, efq, pre_); else E(acc, cur, wr, wc, efr, efq); }
          else { _Pragma("unroll") for (int a = 0; a < 2; ++a) _Pragma("unroll") for (int b = 0; b < 2; ++b) _Pragma("unroll") for (int m = 0; m < 4; ++m) _Pragma("unroll") for (int n = 0; n < 2; ++n) asm volatile("" :: "v"(acc[a][b][m][n])); } }
        if (!has_next) break;
#pragma unroll
        for (int a = 0; a < 2; ++a)
#pragma unroll
            for (int b = 0; b < 2; ++b)
#pragma unroll
                for (int m = 0; m < 4; ++m)
#pragma unroll
                    for (int n = 0; n < 2; ++n) acc[a][b][m][n] = (f32x4){0.f, 0.f, 0.f, 0.f};
        cur = nxt; cA = nA; cB = nB; ++ui;
        if (wr == 1) PG8_BAR;
    }
    PG8_WAIT_V(0);
    PG8_BAR;
#undef PG8_SA
#undef PG8_SB
#undef PG8_STAGE
#undef PG8_LDA
#undef PG8_LDB
#undef PG8_LD8
#undef PG8_LO
#undef PG8_HI
#undef PG8_MMA
#undef PG8_WAIT_V
#undef PG8_WAIT_L
#undef PG8_BAR
#undef PG8_SCHED
}

template <class Epi, class Sched>
__device__ __forceinline__ void gemm_naive(float* slab_all, const Gemm g, const Sched& S, const Epi& E) {
    int tid_ = threadIdx.x; asm volatile("" : "+v"(tid_));
    const int tid = tid_, wid = __builtin_amdgcn_readfirstlane(tid >> 6), lane = tid & 63, wr = wid >> 2, wc = wid & 3, fr = lane & 15, fq = lane >> 4;
    float* slab = slab_all + (size_t)blockIdx.x * 65536;
    Unit u;
    for (int ui = 0; S.next(ui, u); ++ui) {
#pragma unroll 1
        for (int idx = 0; idx < 32; ++idx) {
            const int ai = idx >> 4, m = (idx >> 2) & 3, bj = (idx >> 1) & 1, n = idx & 1;
            const char* ap = u.a + (size_t)(ai * 128 + wr * 64 + m * 16 + fr) * g.lda * 2;
            const char* bp = u.b + (size_t)(bj * 128 + wc * 32 + n * 16 + fq * 4) * g.ldb * 2;
            f32x4 s = (f32x4){0.f, 0.f, 0.f, 0.f};
#pragma unroll 1
            for (int k0 = 0; k0 < g.K; k0 += 8) {
                const u32x4 va = *(const u32x4*)(ap + k0 * 2);
#pragma unroll
                for (int j = 0; j < 4; ++j) { const u32x4 vb = *(const u32x4*)(bp + ((size_t)j * g.ldb + k0) * 2);
#pragma unroll
                    for (int q = 0; q < 4; ++q) s[j] += bf2f(va[q] & 0xffffu) * bf2f(vb[q] & 0xffffu) + bf2f(va[q] >> 16) * bf2f(vb[q] >> 16); }
            }
            *(f32x4*)(slab + ((size_t)tid * 32 + idx) * 4) = s;
        }
        f32x4 acc[2][2][4][2];
#pragma unroll
        for (int ai = 0; ai < 2; ++ai)
#pragma unroll
            for (int m = 0; m < 4; ++m)
#pragma unroll
                for (int bj = 0; bj < 2; ++bj)
#pragma unroll
                    for (int n = 0; n < 2; ++n) acc[ai][bj][m][n] = *(const f32x4*)(slab + (size_t)tid * 128 + (ai * 16 + m * 4 + bj * 2 + n) * 4);
        { int efr = fr, efq = fq; asm volatile("" : "+v"(efr), "+v"(efq)); E(acc, u, wr, wc, efr, efq); }
    }
}
}

template <class Epi, class Sched, bool FP8 = false, int DBG = 0, bool PEEL = false>
__device__ __forceinline__ void run_gemm(LAS unsigned char* lds, unsigned char* g_slab, const pg8::Gemm g, const Sched& S, const Epi& E) {
#if USE_ENGINE
    pg8::gemm_phase<Epi, Sched, FP8, DBG, PEEL>(lds, g, S, E);
#else
    pg8::gemm_naive<Epi, Sched>((float*)(g_slab), g, S, E);
#endif
}

struct Args { const float* in[37]; float* out; unsigned char* ws; int ph_lo, ph_hi; };
enum { I_X = 0, I_C, I_CTX, I_CCTX, I_ADAW, I_ADAB, I_NMPRE, I_NMPOST, I_NFPRE, I_NFPOST, I_WIN, I_WBG, I_BBG, I_WBR, I_WOUT, I_POOLW, I_POOLS,
       I_SARE, I_SAIM, I_SLDT, I_SBRE, I_SBIM, I_SCRE, I_SCIM, I_SD, I_SWGLU, I_LNG, I_LNB, I_GWS, I_GBS, I_RPB, I_RW, I_RB, I_W1, I_B1, I_W2, I_B2 };

struct Ctx {
    const Args* a; unsigned char* ws; LAS unsigned char* lds;
    int tid, lane, wid, G, bid, gw, NGW, brot;
};
#define LAUNDER(cin) Ctx c = cin; c.tid = threadIdx.x; asm volatile("" : "+v"(c.tid)); c.lane = c.tid & 63; c.wid = __builtin_amdgcn_readfirstlane(c.tid >> 6); c.bid = blockIdx.x; if (c.brot) c.bid = (c.bid + c.G - c.brot) % c.G; asm volatile("" : "+s"(c.bid)); c.gw = c.bid * 8 + c.wid
__device__ __forceinline__ const float* xin_row(const Args& a, int row) { return row < NLAT ? a.in[I_X] + (size_t)row * D : a.in[I_CTX] + (size_t)(row - NLAT) * D; }
__device__ __forceinline__ const float* mod_ptr(unsigned char* ws, int l, int row, int which) {
    const int r5 = row < NLAT ? row / SEQ : 4;
    return (const float*)(ws + WS_MODS) + ((size_t)(l * 5 + r5) * 6 + which) * 1024;
}

__device__ __forceinline__ int rowmap(int n, int kind, int NH) {
    if (kind == 0) return n;
    const int half = n >= NH ? 1 : 0, j = n - half * NH; return 256 * (j >> 7) + 128 * half + (j & 127);
}
__device__ __forceinline__ void transpose_item(const float* W, int K, int N, bf16* WT, int ldd, int row_off, int kind, LAS float* scr, int item, int lane) {
    const int nblk = N / 64, kb = item / nblk, nb = item % nblk, k0 = 64 * kb, n0 = 64 * nb;
    f32x4 v[16];
#pragma unroll
    for (int i = 0; i < 16; ++i) v[i] = *(const f32x4*)(W + (size_t)(k0 + 4 * i + (lane >> 4)) * N + n0 + 4 * (lane & 15));
#pragma unroll
    for (int i = 0; i < 16; ++i) { LAS float* d = scr + (4 * i + (lane >> 4)) * 65 + 4 * (lane & 15); d[0] = v[i].x; d[1] = v[i].y; d[2] = v[i].z; d[3] = v[i].w; }
    asm volatile("s_waitcnt lgkmcnt(0)" ::: "memory");
    const int c = lane & 7;
#pragma unroll
    for (int j = 0; j < 8; ++j) { const int n = (lane >> 3) + 8 * j; const LAS float* sp = scr + (8 * c) * 65 + n;
        u32x4 o; o.x = pk2(sp[0 * 65], sp[1 * 65]); o.y = pk2(sp[2 * 65], sp[3 * 65]); o.z = pk2(sp[4 * 65], sp[5 * 65]); o.w = pk2(sp[6 * 65], sp[7 * 65]);
        *(u32x4*)(WT + (size_t)(row_off + rowmap(n0 + n, kind, N / 2)) * ldd + k0 + 8 * c) = o; }
    asm volatile("s_waitcnt lgkmcnt(0)" ::: "memory");
}
__device__ __forceinline__ void tr_store_f8(const float* dummy, bf16* WT8, int k0, int n0, int N, int ldd_bytes, int kind, LAS float* scr, int lane, const f32x4 (&v)[16]) {
#pragma unroll
    for (int i = 0; i < 16; ++i) { LAS float* d = scr + (4 * i + (lane >> 4)) * 65 + 4 * (lane & 15); d[0] = v[i].x; d[1] = v[i].y; d[2] = v[i].z; d[3] = v[i].w; }
    asm volatile("s_waitcnt lgkmcnt(0)" ::: "memory");
    const int c = lane & 3; unsigned char* base = (unsigned char*)WT8;
#pragma unroll
    for (int j = 0; j < 4; ++j) { const int n = (lane >> 2) + 16 * j; const LAS float* sp = scr + (16 * c) * 65 + n;
        u32x4 o; o.x = pk4_fp8(sp[0 * 65] * F8_W, sp[1 * 65] * F8_W, sp[2 * 65] * F8_W, sp[3 * 65] * F8_W); o.y = pk4_fp8(sp[4 * 65] * F8_W, sp[5 * 65] * F8_W, sp[6 * 65] * F8_W, sp[7 * 65] * F8_W);
        o.z = pk4_fp8(sp[8 * 65] * F8_W, sp[9 * 65] * F8_W, sp[10 * 65] * F8_W, sp[11 * 65] * F8_W); o.w = pk4_fp8(sp[12 * 65] * F8_W, sp[13 * 65] * F8_W, sp[14 * 65] * F8_W, sp[15 * 65] * F8_W);
        *(u32x4*)(base + (size_t)rowmap(n0 + n, kind, N / 2) * ldd_bytes + k0 + 16 * c) = o; }
    asm volatile("s_waitcnt lgkmcnt(0)" ::: "memory");
}
__device__ __forceinline__ void transpose_job_f8(const Ctx& c_in, const float* W, size_t sstride, int nmat, int K, int N, unsigned char* WT8, size_t dstride_bytes, int kind) {
    LAUNDER(c_in);
    LAS float* scr = (LAS float*)(c.lds + c.wid * 16640);
    const int nblk = N / 64, per = (K / 64) * nblk, items = per * nmat;
    for (int it = c.gw; it < items; it += c.NGW) { const int mat = it / per, li = it - mat * per, k0 = 64 * (li / nblk), n0 = 64 * (li % nblk);
        const float* Wm = W + (size_t)mat * sstride; f32x4 v[16];
#pragma unroll
        for (int i = 0; i < 16; ++i) v[i] = *(const f32x4*)(Wm + (size_t)(k0 + 4 * i + (c.lane >> 4)) * N + n0 + 4 * (c.lane & 15));
        tr_store_f8(nullptr, (bf16*)(WT8 + (size_t)mat * dstride_bytes), k0, n0, N, K, kind, scr, c.lane, v); }
}
__device__ __forceinline__ void transpose_job(const Ctx& c_in, const float* W, size_t sstride, int nmat, int K, int N, bf16* WT, size_t dstride, int ldd, int row_off, int kind) {
    LAUNDER(c_in);
    LAS float* scr = (LAS float*)(c.lds + c.wid * 16640);
    const int per = (K / 64) * (N / 64), items = per * nmat;
    for (int it = c.gw; it < items; it += c.NGW) { const int mat = it / per;
        transpose_item(W + (size_t)mat * sstride, K, N, WT + (size_t)mat * dstride, ldd, row_off, kind, scr, it - mat * per, c.lane); }
}

__device__ __forceinline__ f32x2 cmul(f32x2 a, f32x2 b) { return (f32x2){a.x * b.x - a.y * b.y, a.x * b.y + a.y * b.x}; }

__device__ __forceinline__ void s5_tables(const Ctx& c_in, int l, int g) {
    LAUNDER(c_in);
    const Args& a = *c.a;
    LAS f32x2* AP = (LAS f32x2*)(c.lds);
    LAS f32x2* BB = (LAS f32x2*)(c.lds + 17408);
    LAS f32x2* CM = (LAS f32x2*)(c.lds + 33792);
    LAS float* KF = (LAS float*)(c.lds + 50176);
    __syncthreads();
    for (int i = c.tid; i < 2 * 64 * 17; i += 512) {
        const int k = i % 17, n = (i / 17) % 64, dir = i / (17 * 64);
        const size_t ia = ((size_t)(l * 2 + dir) * 16 + g) * 64 + n;
        const float are = a.in[I_SARE][ia], aim = a.in[I_SAIM][ia], dt = expf(a.in[I_SLDT][(l * 2 + dir) * 16 + g]);
        const float mag = expf(are * dt * (float)k), ang = aim * dt * (float)k;
        AP[i] = (f32x2){mag * cosf(ang), mag * sinf(ang)};
    }
    for (int i = c.tid; i < 2 * 64 * 16; i += 512) {
        const int q = i % 16, n = (i / 16) % 64, dir = i / (16 * 64);
        const size_t ia = ((size_t)(l * 2 + dir) * 16 + g) * 64 + n;
        const float are = a.in[I_SARE][ia], aim = a.in[I_SAIM][ia], dt = expf(a.in[I_SLDT][(l * 2 + dir) * 16 + g]);
        const float mag = expf(are * dt), ang = aim * dt;
        const f32x2 abm1 = (f32x2){mag * cosf(ang) - 1.f, mag * sinf(ang)};
        const float inv = 1.f / (are * are + aim * aim);
        const f32x2 coef = cmul(abm1, (f32x2){are * inv, -aim * inv});
        const f32x2 b = (f32x2){a.in[I_SBRE][ia * 16 + q], a.in[I_SBIM][ia * 16 + q]};
        BB[i] = cmul(coef, b);
    }
    for (int i = c.tid; i < 2 * 16 * 64; i += 512) {
        const int n = i % 64, p = (i / 64) % 16, dir = i / (64 * 16);
        const size_t ic = (((size_t)(l * 2 + dir) * 16 + g) * 16 + p) * 64 + n;
        CM[i] = (f32x2){a.in[I_SCRE][ic], a.in[I_SCIM][ic]};
    }
    __syncthreads();
    for (int i = c.tid; i < 2 * 16 * 256; i += 512) {
        const int q = i % 16, p = (i / 16) % 16, k = (i / 256) % 16, dir = i / 4096;
        float s = 0.f;
        for (int n = 0; n < 64; ++n) { const f32x2 e = cmul(CM[(dir * 16 + p) * 64 + n], AP[(dir * 64 + n) * 17 + k]); const f32x2 b = BB[(dir * 64 + n) * 16 + q]; s += e.x * b.x - e.y * b.y; }
        KF[i] = s;
    }
    __syncthreads();
    bf16* bt1 = (bf16*)(c.ws + WS_BT1) + (size_t)(l * 16 + g) * 256 * 256;
    bf16* bt3 = (bf16*)(c.ws + WS_BT3) + (size_t)(l * 16 + g) * 256 * 512;
    for (int i = c.tid; i < 256 * 256; i += 512) {
        const int kk = i % 256, j = i / 256, s = kk / 16, q = kk % 16, dir = j / 128, ri = (j / 64) & 1, n = j % 64;
        const f32x2 e = cmul(AP[(dir * 64 + n) * 17 + (dir == 0 ? 15 - s : s)], BB[(dir * 64 + n) * 16 + q]);
        bt1[i] = (bf16)f2bf(ri ? e.y : e.x);
    }
    const float* dvec = a.in[I_SD] + l * 256 + g * 16;
    for (int i = c.tid; i < 256 * 512; i += 512) {
        const int kk = i % 512, j = i / 512, t = j / 16, p = j % 16; float v;
        if (kk < 256) { const int s = kk / 16, q = kk % 16; v = 0.f;
            if (t >= s) v += KF[((0 * 16 + (t - s)) * 16 + p) * 16 + q];
            if (s >= t) v += KF[((1 * 16 + (s - t)) * 16 + p) * 16 + q];
            if (t == s && p == q) v += dvec[p];
        } else { const int k2 = kk - 256, dir = k2 / 128, ri = (k2 / 64) & 1, n = k2 % 64;
            const f32x2 e = cmul(CM[(dir * 16 + p) * 64 + n], AP[(dir * 64 + n) * 17 + (dir == 0 ? t + 1 : 16 - t)]);
            v = ri ? -e.y : e.x; }
        bt3[i] = (bf16)f2bf(v);
    }
    float* a16 = (float*)(c.ws + WS_A16);
    for (int i = c.tid; i < 128; i += 512) { const int dir = i / 64, n = i % 64; const f32x2 e = AP[(dir * 64 + n) * 17 + 16];
        a16[(((size_t)(l * 2 + dir) * 16 + g) * 64 + n) * 2] = e.x; a16[(((size_t)(l * 2 + dir) * 16 + g) * 64 + n) * 2 + 1] = e.y; }
    __syncthreads();
}

__device__ __forceinline__ void phase_prep(const Ctx& c_in) {
    LAUNDER(c_in);
    const Args& a = *c.a; unsigned char* ws = c.ws;
    for (int it = c.bid - 96; it >= 0 && it < DEPTH * 16; it += c.G) s5_tables(c, it / 16, it % 16);
    {
        LAS float* red = (LAS float*)c.lds;
        for (int it = c.bid; it < DEPTH * 48; it += c.G) {
            const int l = it / 48, cb = it % 48, col = cb * 128 + (c.tid & 127), ks = c.tid >> 7;
            float s[5] = {0.f, 0.f, 0.f, 0.f, 0.f};
            const float* w = a.in[I_ADAW] + (size_t)l * 1024 * 6144 + col;
            for (int k0 = ks * 256; k0 < ks * 256 + 256; k0 += 16) {
                float wv[16];
#pragma unroll
                for (int j = 0; j < 16; ++j) wv[j] = w[(size_t)(k0 + j) * 6144];
#pragma unroll
                for (int j = 0; j < 16; ++j) {
#pragma unroll
                    for (int r = 0; r < 5; ++r) { const float cv = r < 4 ? a.in[I_C][r * 1024 + k0 + j] : a.in[I_CCTX][k0 + j]; s[r] += cv * sigmoidf_(cv) * wv[j]; } }
            }
            __syncthreads();
#pragma unroll
            for (int r = 0; r < 5; ++r) red[(ks * 5 + r) * 128 + (c.tid & 127)] = s[r];
            __syncthreads();
            if (c.tid < 128) {
#pragma unroll
                for (int r = 0; r < 5; ++r) { const float v = red[(0 * 5 + r) * 128 + c.tid] + red[(1 * 5 + r) * 128 + c.tid] + red[(2 * 5 + r) * 128 + c.tid] + red[(3 * 5 + r) * 128 + c.tid] + a.in[I_ADAB][l * 6144 + col];
                    ((float*)(ws + WS_MODS))[(size_t)(l * 5 + r) * 6144 + col] = v; }
            }
        }
        __syncthreads();
    }
    if (c.bid == c.G - 1) {
        float* rope = (float*)(ws + WS_ROPE);
        for (int i = c.tid; i < 1040; i += 512) { const int pos = i / 16, j = i % 16; const float inv = powf(10000.f, -(float)j / 16.f), ang = pos < 64 ? (float)pos * inv : 0.f;
            rope[i] = cosf(ang); rope[1040 + i] = sinf(ang); }
    }
    for (int it = c.gw; it < DEPTH * 64; it += c.NGW) {
        const int l = it >> 6, ks = (it >> 1) & 31, nb = it & 1, j = c.lane & 15, kq = c.lane >> 4;
        const float* w = a.in[I_RW] + (size_t)l * D * NEXP + (size_t)(32 * ks + 8 * kq) * NEXP + 16 * nb + j;
        float wv[8]; unsigned hi[4], lo[4];
#pragma unroll
        for (int t = 0; t < 8; ++t) wv[t] = w[(size_t)t * NEXP];
#pragma unroll
        for (int t = 0; t < 4; ++t) { hi[t] = pk2(wv[2 * t], wv[2 * t + 1]); lo[t] = pk2(wv[2 * t] - bf2f(hi[t] & 0xffffu), wv[2 * t + 1] - bf2f(hi[t] >> 16)); }
        u32x4* dst = (u32x4*)(ws + WS_RWF) + (size_t)it * 128;
        dst[c.lane] = (u32x4){hi[0], hi[1], hi[2], hi[3]}; dst[64 + c.lane] = (u32x4){lo[0], lo[1], lo[2], lo[3]};
    }
    for (int i = c.gw * 64 + c.lane; i < DEPTH * 4 * 256 * 128; i += c.NGW * 64) {
        const int q = i % 128, p = (i / 128) % 256, lh = i / (128 * 256);
        ((bf16*)(ws + WS_WST))[i] = p < 128 ? (bf16)f2bf(a.in[I_GWS][((size_t)lh * 128 + p) * 128 + q]) : (bf16)0;
    }
    transpose_job_f8(c, a.in[I_W1], (size_t)D * 2048, DEPTH * NEXP, D, 2048, ws + WS_W1T, (size_t)2048 * D, 1);
    transpose_job_f8(c, a.in[I_W2], (size_t)D * D, DEPTH * NEXP, D, D, ws + WS_W2T, (size_t)D * D, 0);
    transpose_job_f8(c, a.in[I_WBG], (size_t)D * 4096, DEPTH, D, 4096, ws + WS_WBG8, (size_t)4096 * D, 0);
    transpose_job(c, a.in[I_WIN], (size_t)D * INW, DEPTH, D, INW, (bf16*)(ws + WS_WINT), (size_t)NG1 * D, D, 0, 0);
    transpose_job_f8(c, a.in[I_WBR], (size_t)256 * D, DEPTH * 4, 256, D, ws + WS_WBRT, (size_t)D * 256, 0);
    transpose_job(c, a.in[I_WOUT], (size_t)D * D, DEPTH, D, D, (bf16*)(ws + WS_WOUTT), (size_t)D * D, D, 0, 0);
    transpose_job(c, a.in[I_SWGLU], (size_t)256 * 512, DEPTH, 256, 512, (bf16*)(ws + WS_WGLUT), (size_t)512 * 256, 256, 0, 1);
}

__device__ __forceinline__ void load_row(const float* p, int lane, f32x4 (&v)[4]) {
#pragma unroll
    for (int j = 0; j < 4; ++j) v[j] = *(const f32x4*)(p + 4 * lane + 256 * j);
}
__device__ __forceinline__ void load_row_bf(const bf16* p, int lane, f32x4 (&v)[4]) {
#pragma unroll
    for (int j = 0; j < 4; ++j) { const u32x2 w = *(const u32x2*)(p + 4 * lane + 256 * j); v[j] = (f32x4){bf2f(w.x & 0xffffu), bf2f(w.x >> 16), bf2f(w.y & 0xffffu), bf2f(w.y >> 16)}; }
}
__device__ __forceinline__ float row_rms_scale(const f32x4 (&v)[4]) {
    float s = 0.f;
#pragma unroll
    for (int j = 0; j < 4; ++j) s += (v[j].x * v[j].x + v[j].y * v[j].y) + (v[j].z * v[j].z + v[j].w * v[j].w);
    return rsqrtf(wave_sum(s) * (1.f / D) + EPS);
}
template <bool WR_LDS, bool WR_H = true, bool WR_H8 = false>
__device__ __forceinline__ void norm_mod_store(const f32x4 (&x)[4], const float* gw, const float* shift, const float* scale, bf16* hrow, int lane, LAS float* hf, unsigned char* h8row = nullptr) {
    const float r = row_rms_scale(x);
#pragma unroll
    for (int j = 0; j < 4; ++j) {
        const int o = 4 * lane + 256 * j;
        const f32x4 g = *(const f32x4*)(gw + o), sh = *(const f32x4*)(shift + o), sc = *(const f32x4*)(scale + o);
        const f32x4 h = (x[j] * r * g) * (sc + 1.f) + sh;
        u32x2 w; w.x = pk2(h.x, h.y); w.y = pk2(h.z, h.w);
        if (WR_H) *(u32x2*)(hrow + o) = w;
        if (WR_H8) *(unsigned*)(h8row + o) = pk4_fp8(h.x * F8_X, h.y * F8_X, h.z * F8_X, h.w * F8_X);
        if (WR_LDS) { hf[o] = h.x; hf[o + 1] = h.y; hf[o + 2] = h.z; hf[o + 3] = h.w; }
    }
}
constexpr int N2_RS = 2064, N2_LO = 8320, N2_SLOT = 16640;
__device__ __forceinline__ void norm_mod_split(const f32x4 (&x)[4], const float* gw, const float* shift, const float* scale, int lane, LAS unsigned char* rowp) {
    const float r = row_rms_scale(x);
#pragma unroll
    for (int j = 0; j < 4; ++j) {
        const int o = 4 * lane + 256 * j;
        const f32x4 g = *(const f32x4*)(gw + o), sh = *(const f32x4*)(shift + o), sc = *(const f32x4*)(scale + o);
        const f32x4 h = (x[j] * r * g) * (sc + 1.f) + sh;
        u32x2 hi, lo; hi.x = pk2(h.x, h.y); hi.y = pk2(h.z, h.w);
        lo.x = pk2(h.x - bf2f(hi.x & 0xffffu), h.y - bf2f(hi.x >> 16)); lo.y = pk2(h.z - bf2f(hi.y & 0xffffu), h.w - bf2f(hi.y >> 16));
        *(LAS u32x2*)(rowp + o * 2) = hi; *(LAS u32x2*)(rowp + N2_LO + o * 2) = lo;
    }
}
__device__ __forceinline__ void phase_n1_layer0(const Ctx& c_in) {
    LAUNDER(c_in);
    const Args& a = *c.a;
    for (int row = c.gw; row < MT; row += c.NGW) {
        f32x4 x[4]; load_row(xin_row(a, row), c.lane, x);
        norm_mod_store<false, true, true>(x, a.in[I_NMPRE], mod_ptr(c.ws, 0, row, 0), mod_ptr(c.ws, 0, row, 1), (bf16*)(c.ws + WS_H) + (size_t)row * D, c.lane, nullptr, c.ws + WS_H8 + (size_t)row * D);
    }
}

using pg8::Unit;
struct SchedG1 {
    const char* A; const char* B; int nM, nMfull, nN, nNctx, G, c, Lbeg, Lend;
    __device__ __forceinline__ bool next(int i, Unit& u) const {
        const int L = Lbeg + i * G + c, n1 = nM * nNctx; int pm, pn;
        if (L >= Lend) return false;
        if (L < n1) { if (!pg8::plain_order(L, nM, nNctx, pm, pn)) return false; }
        else { if (!pg8::plain_order(L - n1, nMfull, nN - nNctx, pm, pn)) return false; pn += nNctx; }
        u.pm = pm; u.pn = pn; u.aux = 0; u.a = A + (size_t)pm * 256 * D * 2; u.b = B + (size_t)pn * 256 * D * 2; return true;
    }
};
struct SchedGate {
    const char* A; const char* B; int nMfull, G, c, rot;
    __device__ __forceinline__ bool next(int i, Unit& u) const {
        const int U = nMfull * 16, nfr = U / G, X = U - nfr * G, nl = G - rot; int L;
        if (i < nfr) L = i * G + c;
        else if (X <= 2 * nl) { const int x = 2 * (c - rot) + (i - nfr); if (c < rot || i - nfr > 1 || x >= X) return false; L = nfr * G + x; }
        else L = i * G + (c + G - rot) % G;
        int pm, pn; if (!pg8::plain_order(L, nMfull, 16, pm, pn)) return false;
        u.pm = pm; u.pn = 7 + pn; u.aux = 0; u.a = A + (size_t)pm * 256 * D; u.b = B + (size_t)pn * 256 * D; return true;
    }
};
struct PlainSched {
    const char* A; const char* B; int lda, ldb, nM, nN, G, c;
    __device__ __forceinline__ bool next(int i, Unit& u) const {
        int pm, pn; if (!pg8::plain_order(i * G + c, nM, nN, pm, pn)) return false;
        u.pm = pm; u.pn = pn; u.aux = 0; u.a = A + (size_t)pm * 256 * lda * 2; u.b = B + (size_t)pn * 256 * ldb * 2; return true;
    }
};
#define EPI_ROWCOL const int row = row_; const int col = u.pn * 256 + bj * 128 + wc * 32 + n * 16 + fq * 4;
#define EPI_FENCE asm volatile("" ::: "memory")
#define EPI_ROW_OPAQUE int row_ = u.pm * 256 + ai * 128 + wr * 64 + m * 16 + fr; asm volatile("" : "+v"(row_));
#define EPI_LOOP4(...) _Pragma("unroll") for (int ai = 0; ai < 2; ++ai) _Pragma("unroll") for (int m = 0; m < 4; ++m) { EPI_ROW_OPAQUE _Pragma("unroll") for (int bj = 0; bj < 2; ++bj) _Pragma("unroll") for (int n = 0; n < 2; ++n) { __VA_ARGS__ } EPI_FENCE; }
__device__ __forceinline__ u32x4 pack8_swap(f32x4 v0, f32x4 v1) {
    const unsigned x0 = pk2(v0.x, v0.y), x1 = pk2(v0.z, v0.w), y0 = pk2(v1.x, v1.y), y1 = pk2(v1.z, v1.w);
    const u32x2 r0 = __builtin_amdgcn_permlane16_swap(x0, y0, false, false), r1 = __builtin_amdgcn_permlane16_swap(x1, y1, false, false);
    return (u32x4){r0.x, r1.x, r0.y, r1.y};
}
__device__ __forceinline__ void st_bf4(bf16* p, f32x4 v) { u32x2 w; w.x = pk2(v.x, v.y); w.y = pk2(v.z, v.w); *(u32x2*)p = w; }

struct EpiG1 {
    unsigned char* ws; const float* bbg; const float* rope;
    struct Pre { f32x4 b[2][2]; };
    __device__ __forceinline__ void pre(const Unit& u, int wc, int fq, Pre& p) const {
#pragma unroll
        for (int bj = 0; bj < 2; ++bj)
#pragma unroll
            for (int n = 0; n < 2; ++n) p.b[bj][n] = *(const f32x4*)(bbg + (u.pn >= 7 ? u.pn * 256 - INW : 0) + bj * 128 + wc * 32 + n * 16 + fq * 4);
    }
    __device__ __forceinline__ void operator()(const f32x4 (&acc)[2][2][4][2], const Unit& u, int wr, int wc, int fr, int fq, const Pre& p) const {
        bf16* GT = (bf16*)(ws + WS_GATES);
        const int cs = (fq & 1) ? 12 + 4 * fq : 4 * fq;
#pragma unroll
        for (int ai = 0; ai < 2; ++ai)
#pragma unroll
            for (int m = 0; m < 4; ++m) { EPI_ROW_OPAQUE
#pragma unroll
                for (int bj = 0; bj < 2; ++bj) { const int gc0 = u.pn * 256 + bj * 128 + wc * 32 - INW;
                    const f32x4 v0 = acc[ai][bj][m][0] * (1.f / (F8_W * F8_X)) + p.b[bj][0], v1 = acc[ai][bj][m][1] * (1.f / (F8_W * F8_X)) + p.b[bj][1];
                    const unsigned q0 = pk4_u8(sigmoid_g(v0.x), sigmoid_g(v0.y), sigmoid_g(v0.z), sigmoid_g(v0.w));
                    const unsigned q1 = pk4_u8(sigmoid_g(v1.x), sigmoid_g(v1.y), sigmoid_g(v1.z), sigmoid_g(v1.w));
                    *(u32x2*)((unsigned char*)GT + (size_t)row_ * 4096 + gc0 + cs) = __builtin_amdgcn_permlane16_swap(q0, q1, false, false); }
                EPI_FENCE; }
    }
    __device__ __forceinline__ void operator()(const f32x4 (&acc)[2][2][4][2], const Unit& u, int wr, int wc, int fr, int fq) const {
        bf16* P = (bf16*)(ws + WS_P);
        if (u.pn >= 7) {
            bf16* GT = (bf16*)(ws + WS_GATES);
            const int cs = (fq & 1) ? 12 + 4 * fq : 4 * fq;
#pragma unroll
            for (int ai = 0; ai < 2; ++ai)
#pragma unroll
                for (int m = 0; m < 4; ++m) { EPI_ROW_OPAQUE
#pragma unroll
                    for (int bj = 0; bj < 2; ++bj) { const int gc0 = u.pn * 256 + bj * 128 + wc * 32 - INW;
                        const f32x4 v0 = acc[ai][bj][m][0] * (1.f / (F8_W * F8_X)) + *(const f32x4*)(bbg + gc0 + fq * 4), v1 = acc[ai][bj][m][1] * (1.f / (F8_W * F8_X)) + *(const f32x4*)(bbg + gc0 + 16 + fq * 4);
                        const unsigned q0 = pk4_u8(sigmoid_g(v0.x), sigmoid_g(v0.y), sigmoid_g(v0.z), sigmoid_g(v0.w));
                        const unsigned q1 = pk4_u8(sigmoid_g(v1.x), sigmoid_g(v1.y), sigmoid_g(v1.z), sigmoid_g(v1.w));
                        *(u32x2*)((unsigned char*)GT + (size_t)row_ * 4096 + gc0 + cs) = __builtin_amdgcn_permlane16_swap(q0, q1, false, false); }
                    EPI_FENCE; }
        } else if (u.pn == 1) {
            bf16* AC = (bf16*)(ws + WS_ACAT);
            EPI_LOOP4( EPI_ROWCOL const int cc = col - 256; st_bf4(AC + ((size_t)(row >> 4) * 16 + (cc >> 4)) * 512 + (row & 15) * 16 + (cc & 15), acc[ai][bj][m][n]); )
        } else if (u.pn == 2 || u.pn == 3) {
            const int cs8 = (fq & 1) ? 12 + 4 * fq : 4 * fq;
#pragma unroll
            for (int ai = 0; ai < 2; ++ai)
#pragma unroll
                for (int m = 0; m < 4; ++m) { EPI_ROW_OPAQUE
#pragma unroll
                    for (int bj = 0; bj < 2; ++bj) { const f32x4 v0 = acc[ai][bj][m][0], v1 = acc[ai][bj][m][1];
                        *(u32x4*)(P + (size_t)row_ * INW + u.pn * 256 + bj * 128 + wc * 32 + cs8) = pack8_swap((f32x4){gelu_tanh(v0.x), gelu_tanh(v0.y), gelu_tanh(v0.z), gelu_tanh(v0.w)},
                                                                                                                 (f32x4){gelu_tanh(v1.x), gelu_tanh(v1.y), gelu_tanh(v1.z), gelu_tanh(v1.w)}); }
                    EPI_FENCE; }
        } else if (u.pn == 4 || u.pn == 5) {
            const float qs = u.pn == 4 ? 0.125f : 1.f;
            const int cs8 = (fq & 1) ? 12 + 4 * fq : 4 * fq;
#pragma unroll
            for (int ai = 0; ai < 2; ++ai) {
                f32x4 cs[4], sn[4]; int rows[4];
#pragma unroll
                for (int m = 0; m < 4; ++m) { EPI_ROW_OPAQUE rows[m] = row_;
                    const int t = row_ & (SEQ - 1), pos = row_ < NLAT ? ((wc & 1) ? (t & 63) : (t >> 6)) : 64;
                    cs[m] = *(const f32x4*)(rope + pos * 16 + 4 * fq); sn[m] = *(const f32x4*)(rope + 1040 + pos * 16 + 4 * fq); }
#pragma unroll
                for (int m = 0; m < 4; ++m) {
#pragma unroll
                    for (int bj = 0; bj < 2; ++bj) {
                        const f32x4 x1 = acc[ai][bj][m][0], x2 = acc[ai][bj][m][1];
                        *(u32x4*)(P + (size_t)rows[m] * INW + u.pn * 256 + bj * 128 + wc * 32 + cs8) = pack8_swap((x1 * cs[m] - x2 * sn[m]) * qs, (x2 * cs[m] + x1 * sn[m]) * qs);
                    }
                }
                EPI_FENCE;
            }
        } else if (u.pn == 6) {
            bf16* VT2 = (bf16*)(ws + WS_VT2);
            EPI_LOOP4( EPI_ROWCOL const f32x4 v = acc[ai][bj][m][n]; bf16* vp = VT2 + (size_t)(col - 1536) * MT + row;
                vp[0] = (bf16)f2bf(v.x); vp[MT] = (bf16)f2bf(v.y); vp[2 * MT] = (bf16)f2bf(v.z); vp[3 * MT] = (bf16)f2bf(v.w); )
        } else {
            const int cs8 = (fq & 1) ? 12 + 4 * fq : 4 * fq;
#pragma unroll
            for (int ai = 0; ai < 2; ++ai)
#pragma unroll
                for (int m = 0; m < 4; ++m) { EPI_ROW_OPAQUE
#pragma unroll
                    for (int bj = 0; bj < 2; ++bj) *(u32x4*)(P + (size_t)row_ * INW + u.pn * 256 + bj * 128 + wc * 32 + cs8) = pack8_swap(acc[ai][bj][m][0], acc[ai][bj][m][1]);
                    EPI_FENCE; }
        }
    }
};
struct SchedS5 {
    const char* A; const char* B; int Kb, G, c;
    __device__ __forceinline__ bool next(int i, Unit& u) const {
        const int L = i * G + c; if (L >= 80) return false;
        u.pm = L % 5; u.aux = L / 5; u.pn = 0; u.a = A + ((size_t)u.pm * 256 * 8192 + u.aux * 512) * 2; u.b = B + (size_t)u.aux * 256 * Kb * 2; return true;
    }
};
struct EpiS1 {
    float* sst;
    __device__ __forceinline__ void operator()(const f32x4 (&acc)[2][2][4][2], const Unit& u, int wr, int wc, int fr, int fq) const {
        EPI_LOOP4( EPI_ROWCOL if (row < NCHUNK) *(f32x4*)(sst + ((size_t)row * 16 + u.aux) * 256 + col) = acc[ai][bj][m][n]; )
    }
};
struct EpiS3 {
    bf16* yg;
    __device__ __forceinline__ void operator()(const f32x4 (&acc)[2][2][4][2], const Unit& u, int wr, int wc, int fr, int fq) const {
        EPI_LOOP4( EPI_ROWCOL if (row < NCHUNK) { const f32x4 v = acc[ai][bj][m][n];
            st_bf4(yg + ((size_t)row * 16 + (col >> 4)) * 256 + u.aux * 16 + (col & 15), (f32x4){gelu_tanh(v.x), gelu_tanh(v.y), gelu_tanh(v.z), gelu_tanh(v.w)}); } )
    }
};
struct EpiGLU {
    bf16* br;
    __device__ __forceinline__ void operator()(const f32x4 (&acc)[2][2][4][2], const Unit& u, int wr, int wc, int fr, int fq) const {
#pragma unroll
        for (int ai = 0; ai < 2; ++ai)
#pragma unroll
            for (int m = 0; m < 4; ++m) { EPI_ROW_OPAQUE
#pragma unroll
                for (int n = 0; n < 2; ++n) {
                    const int row = row_, colh = wc * 32 + n * 16 + fq * 4;
                    const f32x4 v = acc[ai][0][m][n], g = acc[ai][1][m][n];
                    *(unsigned*)((unsigned char*)br + (size_t)row * D + 256 + u.pn * 128 + colh) = pk4_fp8(v.x * sigmoidf_(g.x) * F8_B, v.y * sigmoidf_(g.y) * F8_B, v.z * sigmoidf_(g.z) * F8_B, v.w * sigmoidf_(g.w) * F8_B);
                } EPI_FENCE; }
    }
};
struct SchedGM {
    const char* A; const char* B; int G, c;
    __device__ __forceinline__ bool next(int i, Unit& u) const {
        const int L = i * G + c; if (c < 0 || L >= 136) return false;
        u.pm = L % 34; u.aux = L / 34; u.pn = 0; u.a = A + ((size_t)u.aux * 8704 + (size_t)u.pm * 256) * 128 * 2; u.b = B + (size_t)u.aux * 256 * 128 * 2; return true;
    }
};
struct EpiGM {
    const bf16* P; bf16* br; const float* bs;
    __device__ __forceinline__ void operator()(const f32x4 (&acc)[2][2][4][2], const Unit& u, int wr, int wc, int fr, int fq) const {
        const int h = u.aux;
#pragma unroll
        for (int ai = 0; ai < 2; ++ai)
#pragma unroll
            for (int m = 0; m < 4; ++m) { EPI_ROW_OPAQUE
#pragma unroll
                for (int n = 0; n < 2; ++n) {
                    const int row = row_, chunk = row >> 6, ch = row & 63, p0 = wc * 32 + n * 16 + fq * 4;
                    const f32x4 v = acc[ai][0][m][n];
#pragma unroll
                    for (int j = 0; j < 4; ++j) { const int tok = chunk * 128 + p0 + j; const size_t o = (size_t)tok * INW + 512 + h * 64 + ch;
                        br[(size_t)tok * D + 512 + h * 64 + ch] = (bf16)f2bf((v[j] + bs[h * 128 + p0 + j]) * bf2f(P[o])); }
                } EPI_FENCE; }
    }
};
struct SchedG2 {
    const char* A; const char* B; int G, c;
    __device__ __forceinline__ bool next(int i, Unit& u) const {
        const int tile = (i >> 2) * G + c; if (tile >= 68 * 4) return false;
        u.aux = i & 3; u.pm = tile >> 2; u.pn = tile & 3; u.a = A + ((size_t)u.pm * 256 * D + u.aux * 256) * 2; u.b = B + ((size_t)u.aux * D * 256 + (size_t)u.pn * 256 * 256) * 2; return true;
    }
};
struct EpiG2 {
    const bf16* gates; float* mrgf; bf16* mrg;
    __device__ __forceinline__ void operator()(const f32x4 (&acc)[2][2][4][2], const Unit& u, int wr, int wc, int fr, int fq) const {
        const int i = u.aux;
        EPI_LOOP4( EPI_ROWCOL const u32x2 gw = *(const u32x2*)(gates + (size_t)row * 4096 + i * 1024 + col);
            const f32x4 g = (f32x4){bf2f(gw.x & 0xffffu), bf2f(gw.x >> 16), bf2f(gw.y & 0xffffu), bf2f(gw.y >> 16)};
            f32x4 v = acc[ai][bj][m][n] * g; float* mp = mrgf + (size_t)row * D + col;
            if (i > 0) v += *(const f32x4*)mp;
            if (i < 3) *(f32x4*)mp = v; else st_bf4(mrg + (size_t)row * D + col, v); )
    }
};
struct EpiBF {
    bf16* o; int ldc;
    __device__ __forceinline__ void operator()(const f32x4 (&acc)[2][2][4][2], const Unit& u, int wr, int wc, int fr, int fq) const {
        const int cs = (fq & 1) ? 12 + 4 * fq : 4 * fq;
#pragma unroll
        for (int ai = 0; ai < 2; ++ai)
#pragma unroll
            for (int m = 0; m < 4; ++m) { EPI_ROW_OPAQUE
#pragma unroll
                for (int bj = 0; bj < 2; ++bj) *(u32x4*)(o + (size_t)row_ * ldc + u.pn * 256 + bj * 128 + wc * 32 + cs) = pack8_swap(acc[ai][bj][m][0], acc[ai][bj][m][1]);
                EPI_FENCE; }
    }
};
struct EpiF32 {
    float* o; int ldc;
    __device__ __forceinline__ void operator()(const f32x4 (&acc)[2][2][4][2], const Unit& u, int wr, int wc, int fr, int fq) const {
        EPI_LOOP4( EPI_ROWCOL *(f32x4*)(o + (size_t)row * ldc + col) = acc[ai][bj][m][n]; )
    }
};
struct SchedMoE {
    const char* A; const char* B; const LAS int* ts; int nN, G, c; size_t bstride; bool a_sparse;
    __device__ __forceinline__ bool next(int i, Unit& u) const {
        const int L = i * G + c, nt = ts[32]; if (L >= nt * nN) return false;
        const int j = L / nN; int e = 0;
#pragma unroll
        for (int st = 16; st >= 1; st >>= 1) if (ts[e + st] <= j) e += st;
        const size_t arow = a_sparse ? (size_t)e * MOE_CAP + (size_t)(j - ts[e]) * 256 : (size_t)j * 256;
        u.pm = j; u.pn = L % nN; u.aux = e; u.a = A + arow * D; u.b = B + (size_t)e * bstride + (size_t)u.pn * 256 * D; return true;
    }
};
struct EpiE1 {
    bf16* act; const float* b1;
    struct Pre { f32x4 bg[2], bl[2]; };
    __device__ __forceinline__ void pre(const Unit& u, int wc, int fq, Pre& p) const {
        const float* bb = b1 + (size_t)u.aux * 2048;
#pragma unroll
        for (int n = 0; n < 2; ++n) { const int c0 = u.pn * 128 + wc * 32 + n * 16 + fq * 4; p.bg[n] = *(const f32x4*)(bb + c0); p.bl[n] = *(const f32x4*)(bb + 1024 + c0); }
    }
    __device__ __forceinline__ void operator()(const f32x4 (&acc)[2][2][4][2], const Unit& u, int wr, int wc, int fr, int fq) const { Pre p; pre(u, wc, fq, p); (*this)(acc, u, wr, wc, fr, fq, p); }
    __device__ __forceinline__ void operator()(const f32x4 (&acc)[2][2][4][2], const Unit& u, int wr, int wc, int fr, int fq, const Pre& p) const {
        f32x4 bg[2], bl[2];
#pragma unroll
        for (int n = 0; n < 2; ++n) { bg[n] = p.bg[n]; bl[n] = (p.bl[n] + 1.f) * F8_ACT; }
#pragma unroll
        for (int ai = 0; ai < 2; ++ai)
#pragma unroll
            for (int m = 0; m < 4; ++m) { EPI_ROW_OPAQUE
                unsigned pq[2];
#pragma unroll
                for (int n = 0; n < 2; ++n) {
                    const f32x4 hg = acc[ai][0][m][n] * (1.f / (F8_W * F8_X)) + bg[n], hl = acc[ai][1][m][n] * (F8_ACT / (F8_W * F8_X)) + bl[n];
                    f32x4 g, li4, ex, sg;
#pragma unroll
                    for (int j = 0; j < 4; ++j) { g[j] = fminf(hg[j], 7.f); li4[j] = __builtin_amdgcn_fmed3f(hl[j], -6.f * F8_ACT, 8.f * F8_ACT); }
                    const f32x4 ar = g * (-1.702f * 1.4426950408889634f);
#pragma unroll
                    for (int j = 0; j < 4; ++j) ex[j] = __builtin_amdgcn_exp2f(ar[j]);
                    const f32x4 dn = ex + 1.f;
#pragma unroll
                    for (int j = 0; j < 4; ++j) sg[j] = __builtin_amdgcn_rcpf(dn[j]);
                    const f32x4 o = (g * sg) * li4;
                    pq[n] = pk4_fp8_nc(o[0], o[1], o[2], o[3]);
                }
                { const u32x2 r = __builtin_amdgcn_permlane16_swap(pq[0], pq[1], false, false);
                  *(u32x2*)((unsigned char*)act + (size_t)row_ * D + u.pn * 128 + wc * 32 + ((fq & 1) ? 12 + 4 * fq : 4 * fq)) = r; }
                EPI_FENCE; }
    }
};
struct EpiE2 {
    bf16* yb; const float* b2;
    struct Pre { f32x4 bv[2][2]; };
    __device__ __forceinline__ void pre(const Unit& u, int wc, int fq, Pre& p) const {
        const float* bb = b2 + (size_t)u.aux * 1024;
#pragma unroll
        for (int bj = 0; bj < 2; ++bj)
#pragma unroll
            for (int n = 0; n < 2; ++n) p.bv[bj][n] = *(const f32x4*)(bb + u.pn * 256 + bj * 128 + wc * 32 + n * 16 + fq * 4);
    }
    __device__ __forceinline__ void operator()(const f32x4 (&acc)[2][2][4][2], const Unit& u, int wr, int wc, int fr, int fq) const { Pre p; pre(u, wc, fq, p); (*this)(acc, u, wr, wc, fr, fq, p); }
    __device__ __forceinline__ void operator()(const f32x4 (&acc)[2][2][4][2], const Unit& u, int wr, int wc, int fr, int fq, const Pre& p) const {
        const f32x4 (&bv)[2][2] = p.bv;
        const int cs = (fq & 1) ? 12 + 4 * fq : 4 * fq;
#pragma unroll
        for (int ai = 0; ai < 2; ++ai)
#pragma unroll
            for (int m = 0; m < 4; ++m) { EPI_ROW_OPAQUE
#pragma unroll
                for (int bj = 0; bj < 2; ++bj) { const f32x4 v0 = acc[ai][bj][m][0] * (F8_Y / (F8_W * F8_ACT)) + bv[bj][0] * F8_Y, v1 = acc[ai][bj][m][1] * (F8_Y / (F8_W * F8_ACT)) + bv[bj][1] * F8_Y;
                    const u32x2 r = __builtin_amdgcn_permlane16_swap(pk4_fp8(v0.x, v0.y, v0.z, v0.w), pk4_fp8(v1.x, v1.y, v1.z, v1.w), false, false);
                    *(u32x2*)((unsigned char*)yb + (size_t)row_ * D + u.pn * 256 + bj * 128 + wc * 32 + cs) = r; }
                EPI_FENCE; }
    }
};


__device__ __forceinline__ void gemm_merge(LAS unsigned char* lds, const char* BRp, const char* WBRTp, const bf16* gates, bf16* mrg, int nMt, int G, int cid) {
    using namespace pg8;
    int tid_ = threadIdx.x; asm volatile("" : "+v"(tid_));
    const int tid = tid_, wid = __builtin_amdgcn_readfirstlane(tid >> 6), lane = tid & 63, wr = wid >> 2, wc = wid & 3, fr = lane & 15, fq = lane >> 4;
    unsigned voffA[2], voffB[2];
#pragma unroll
    for (int i = 0; i < 2; ++i) { int R, C; stage_rc(tid * 16 + i * 8192, R, C); voffA[i] = (unsigned)(R * D + C * 2); voffB[i] = (unsigned)(R * 256 + C * 2); }
    const unsigned ldsw = (unsigned)wid * 1024u;
    const int aoff = lds_byte(wr * 64 + fr, fq * 8), boff = lds_byte(wc * 32 + fr, fq * 8);
#define GM_SA(b, h) (((b) * 2 + (h)) * HTB)
#define GM_SB(b) ((4 + (b) * 2) * HTB)
#define GM_STAGE(bufoff, gbase, voff) do { _Pragma("unroll") for (int _i = 0; _i < 2; ++_i) \
        __builtin_amdgcn_global_load_lds((const unsigned*)((const char*)(gbase) + (voff)[_i]), (LAS unsigned*)(lds + (bufoff) + ldsw + _i * 8192), 16, 0, 0); } while (0)
#define GM_LD8(p_) ({ const u32x4 lo_ = *(const LAS u32x4*)(p_), hi_ = *(const LAS u32x4*)((p_) + 1024); (v8i32){(int)lo_.x, (int)lo_.y, (int)lo_.z, (int)lo_.w, (int)hi_.x, (int)hi_.y, (int)hi_.z, (int)hi_.w}; })
    for (int L = cid; L < nMt * 8; L += G) {
        const int pm = L >> 3, pn2 = L & 7;
        const char* cA = uptr(BRp + (size_t)pm * 256 * D);
        const char* cB = uptr(WBRTp + (size_t)pn2 * 128 * 256);
        f32x4 acc[2][4][2], mg[2][4][2];
#pragma unroll
        for (int a = 0; a < 2; ++a)
#pragma unroll
            for (int m = 0; m < 4; ++m)
#pragma unroll
                for (int n = 0; n < 2; ++n) { acc[a][m][n] = (f32x4){0.f, 0.f, 0.f, 0.f}; mg[a][m][n] = (f32x4){0.f, 0.f, 0.f, 0.f}; }
#define GM_STAGE_TILE(t, b) do { const char* a_ = cA + (size_t)(t) * 128; const char* b_ = cB + (size_t)((t) >> 1) * (1024 * 256) + (size_t)((t) & 1) * 128; \
        asm volatile("" : "+s"(a_), "+s"(b_)); GM_STAGE(GM_SA(b, 0), a_, voffA); GM_STAGE(GM_SA(b, 1), a_ + (size_t)128 * D, voffA); GM_STAGE(GM_SB(b), b_, voffB); } while (0)
        GM_STAGE_TILE(0, 0); GM_STAGE_TILE(1, 1);
        asm volatile("s_waitcnt vmcnt(6)" ::: "memory"); __builtin_amdgcn_s_barrier();
        unsigned gpre[2][4][2];
#pragma unroll
        for (int t = 0; t < 8; ++t) {
            const int b = t & 1;
            if ((t & 1) == 0) {
                const int i = t >> 1;
#pragma unroll
                for (int ai = 0; ai < 2; ++ai)
#pragma unroll
                    for (int m = 0; m < 4; ++m) {
                        int row_ = pm * 256 + ai * 128 + wr * 64 + m * 16 + fr; asm volatile("" : "+v"(row_));
#pragma unroll
                        for (int n = 0; n < 2; ++n) gpre[ai][m][n] = *(const unsigned*)((const unsigned char*)gates + (size_t)row_ * 4096 + i * 1024 + pn2 * 128 + wc * 32 + n * 16 + fq * 4);
                    }
            }
            v8i32 At[4], B0[2];
#pragma unroll
            for (int n = 0; n < 2; ++n) B0[n] = GM_LD8(lds + GM_SB(b) + boff + n * 2048);
#pragma unroll
            for (int ai = 0; ai < 2; ++ai) {
#pragma unroll
                for (int m = 0; m < 4; ++m) At[m] = GM_LD8(lds + GM_SA(b, ai) + aoff + m * 2048);
                asm volatile("s_waitcnt lgkmcnt(0)" ::: "memory");
#pragma unroll
                for (int m = 0; m < 4; ++m)
#pragma unroll
                    for (int n = 0; n < 2; ++n)
                        asm volatile("s_nop 1\n\tv_mfma_f32_16x16x128_f8f6f4 %0, %1, %2, %0" : "+v"(acc[ai][m][n]) : "v"(B0[n]), "v"(At[m]));
                asm volatile("s_nop 7" ::: "memory");
            }
            __builtin_amdgcn_s_barrier();
            if (t + 2 < 8) { GM_STAGE_TILE(t + 2, b); if ((t & 1) == 0) asm volatile("s_waitcnt vmcnt(22)" ::: "memory"); else asm volatile("s_waitcnt vmcnt(6)" ::: "memory"); }
            else asm volatile("s_waitcnt vmcnt(0)" ::: "memory");
            __builtin_amdgcn_s_barrier();
            if ((t & 1) == 1) {
                asm volatile("s_nop 15\n\ts_nop 15" ::: "memory");
#pragma unroll
                for (int ai = 0; ai < 2; ++ai)
#pragma unroll
                    for (int m = 0; m < 4; ++m)
#pragma unroll
                        for (int n = 0; n < 2; ++n) asm volatile("" : "+v"(acc[ai][m][n]));
#pragma unroll
                for (int ai = 0; ai < 2; ++ai)
#pragma unroll
                    for (int m = 0; m < 4; ++m)
#pragma unroll
                        for (int n = 0; n < 2; ++n) {
                            const unsigned gw = gpre[ai][m][n];
                            const f32x4 g = (f32x4){(float)(gw & 0xffu), (float)((gw >> 8) & 0xffu), (float)((gw >> 16) & 0xffu), (float)(gw >> 24)} * (1.f / (F8_G * F8_W * F8_B));
                            mg[ai][m][n] += acc[ai][m][n] * g; acc[ai][m][n] = (f32x4){0.f, 0.f, 0.f, 0.f};
                        }
            }
        }
#pragma unroll
        for (int ai = 0; ai < 2; ++ai)
#pragma unroll
            for (int m = 0; m < 4; ++m) {
                int row_ = pm * 256 + ai * 128 + wr * 64 + m * 16 + fr; asm volatile("" : "+v"(row_));
                *(u32x4*)(mrg + (size_t)row_ * D + pn2 * 128 + wc * 32 + ((fq & 1) ? 12 + 4 * fq : 4 * fq)) = pack8_swap(mg[ai][m][0], mg[ai][m][1]);
            }
    }
#undef GM_LD8
#undef GM_SA
#undef GM_SB
#undef GM_STAGE
#undef GM_STAGE_TILE
}

template <int G>
__device__ __forceinline__ void pool_item(const Ctx& c, int l, int blk, int hf, const bf16x8 (&wf)[4][2], const f32x4 (&psc)[4], LAS unsigned char* tile) {
    constexpr int H = 1 << G, NV = 32 + 2 * H;
    const bf16* P = (const bf16*)(c.ws + WS_P); bf16* br = (bf16*)(c.ws + WS_BR8);
    const int row0 = blk * 64 + hf * 32;
    int base, Lq;
    if (row0 < NLAT) { base = row0 & ~(SEQ - 1); Lq = SEQ; } else { base = NLAT + ((row0 - NLAT) & ~(CTXL - 1)); Lq = CTXL; }
    const int tq = row0 - base;
    float v[NV];
#pragma unroll
    for (int jj = 0; jj < NV; ++jj) { const int j = tq - H + jj; const bool ok = j >= 0 && j < Lq;
        v[jj] = ok ? bf2f(P[(size_t)(base + (ok ? j : 0)) * INW + G * 64 + c.lane]) : 0.f; }
    float run = 0.f, lo_[32];
    float S[NV + 1];
    S[0] = 0.f;
#pragma unroll
    for (int k = 0; k < NV; ++k) { run += v[k]; S[k + 1] = run; }
    (void)lo_;
#pragma unroll
    for (int i = 0; i < 32; ++i) {
        const int t = tq + i; int lo = t - H, hi = t + H; lo = lo < 0 ? 0 : lo; hi = hi > Lq ? Lq : hi;
        const float d = (S[i + 2 * H] - S[i]) * (1.f / (float)(hi - lo)) - v[i + H];
        *(LAS bf16*)(tile + i * 144 + c.lane * 2) = (bf16)f2bf(d);
    }
    asm volatile("s_waitcnt lgkmcnt(0)" ::: "memory");
    const int fr = c.lane & 15, fq = c.lane >> 4;
    f32x4 acc[2][4];
#pragma unroll
    for (int mb = 0; mb < 2; ++mb)
#pragma unroll
        for (int nb = 0; nb < 4; ++nb) acc[mb][nb] = (f32x4){0.f, 0.f, 0.f, 0.f};
#pragma unroll
    for (int mb = 0; mb < 2; ++mb)
#pragma unroll
        for (int kh = 0; kh < 2; ++kh) {
            const bf16x8 df = *(const LAS bf16x8*)(tile + (16 * mb + fr) * 144 + (32 * kh + 8 * fq) * 2);
#pragma unroll
            for (int nb = 0; nb < 4; ++nb) acc[mb][nb] = __builtin_amdgcn_mfma_f32_16x16x32_bf16(wf[nb][kh], df, acc[mb][nb], 0, 0, 0);
        }
#pragma unroll
    for (int mb = 0; mb < 2; ++mb)
#pragma unroll
        for (int nb = 0; nb < 4; ++nb) { const f32x4 v_ = acc[mb][nb] * psc[nb] * F8_B; *(unsigned*)((unsigned char*)br + (size_t)(row0 + 16 * mb + fr) * D + G * 64 + 16 * nb + 4 * fq) = pk4_fp8(v_.x, v_.y, v_.z, v_.w); }
    asm volatile("s_waitcnt lgkmcnt(0)" ::: "memory");
}
template <int G>
__device__ __forceinline__ void pool_wave(const Ctx& c, int l, int nblk, int hf, LAS unsigned char* tile) {
    const Args& a = *c.a;
    const int fr = c.lane & 15, fq = c.lane >> 4;
    const float* W = a.in[I_POOLW] + ((size_t)l * 4 + G) * 4096;
    bf16x8 wf[4][2]; f32x4 psc[4];
#pragma unroll
    for (int nb = 0; nb < 4; ++nb) {
#pragma unroll
        for (int kh = 0; kh < 2; ++kh) {
            float w8[8];
#pragma unroll
            for (int e = 0; e < 8; ++e) w8[e] = W[(32 * kh + 8 * fq + e) * 64 + 16 * nb + fr];
            u32x4 pk; pk.x = pk2(w8[0], w8[1]); pk.y = pk2(w8[2], w8[3]); pk.z = pk2(w8[4], w8[5]); pk.w = pk2(w8[6], w8[7]);
            wf[nb][kh] = __builtin_bit_cast(bf16x8, pk);
        }
        psc[nb] = *(const f32x4*)(a.in[I_POOLS] + l * 256 + G * 64 + 16 * nb + 4 * fq);
    }
    for (int blk = c.bid; blk < nblk; blk += c.G) pool_item<G>(c, l, blk, hf, wf, psc, tile);
}
__device__ __forceinline__ void phase_pool(const Ctx& c_in, int l) {
    LAUNDER(c_in);
    __syncthreads();
    LAS unsigned char* tile = c.lds + c.wid * 4608;
    const int g = c.wid & 3, hf = c.wid >> 2, nblk = (l == DEPTH - 1) ? NLAT / 64 : MT / 64;
    if (g == 0) pool_wave<0>(c, l, nblk, hf, tile);
    else if (g == 1) pool_wave<1>(c, l, nblk, hf, tile);
    else if (g == 2) pool_wave<2>(c, l, nblk, hf, tile);
    else pool_wave<3>(c, l, nblk, hf, tile);
    __syncthreads();
}
__device__ __forceinline__ void phase_gmlp_ln(const Ctx& c_in, int l) {
    LAUNDER(c_in);
    const Args& a = *c.a;
    LAS bf16* tl = (LAS bf16*)c.lds;
    const bf16* P = (const bf16*)(c.ws + WS_P); bf16* VT = (bf16*)(c.ws + WS_VT);
    for (int chunk = c.bid; chunk < MT / 128; chunk += c.G) {
        __syncthreads();
        for (int q = c.wid; q < 128; q += 8) {
            const int row = chunk * 128 + q;
            const u32x2 w = *(const u32x2*)(P + (size_t)row * INW + 768 + 4 * c.lane);
            f32x4 v = (f32x4){bf2f(w.x & 0xffffu), bf2f(w.x >> 16), bf2f(w.y & 0xffffu), bf2f(w.y >> 16)};
            const float mu = wave_sum((v.x + v.y) + (v.z + v.w)) * (1.f / 256.f);
            v = v - mu;
            const float var = wave_sum((v.x * v.x + v.y * v.y) + (v.z * v.z + v.w * v.w)) * (1.f / 256.f);
            const float r = rsqrtf(var + EPS);
            const f32x4 g = *(const f32x4*)(a.in[I_LNG] + l * 256 + 4 * c.lane), b = *(const f32x4*)(a.in[I_LNB] + l * 256 + 4 * c.lane);
            v = v * r * g + b;
#pragma unroll
            for (int j = 0; j < 4; ++j) tl[(4 * c.lane + j) * 130 + q] = (bf16)f2bf(v[j]);
        }
        __syncthreads();
        for (int i = c.tid; i < 256 * 64; i += 512) {
            const int ch = i >> 6, q2 = i & 63, h = ch >> 6, cc = ch & 63;
            const unsigned w = (unsigned)tl[ch * 130 + 2 * q2] | ((unsigned)tl[ch * 130 + 2 * q2 + 1] << 16);
            *(unsigned*)(VT + ((size_t)h * 8704 + (size_t)chunk * 64 + cc) * 128 + 2 * q2) = w;
        }
    }
    __syncthreads();
}
__device__ __forceinline__ void phase_attn(const Ctx& c_in, int l, bool with_ctx_q) {
    LAUNDER(c_in);
    const Args& a = *c.a;
    LAS float* pw = (LAS float*)(c.lds) + c.wid * 512;
    const bf16* P = (const bf16*)(c.ws + WS_P); bf16* br = (bf16*)(c.ws + WS_BR);
    const float* rpb = a.in[I_RPB] + (size_t)l * 4 * 15 * 31;
    const int nq = with_ctx_q ? MT : NLAT;
    for (int it = c.gw; it < nq * 4; it += c.NGW) {
        const int row = it >> 2, h = it & 3;
        const bool lat = row < NLAT;
        const int b = lat ? row / SEQ : (row - NLAT) / CTXL;
        int r = 0, ci = 0, rs = 0, cs = 0;
        if (lat) { const int t = row & (SEQ - 1); r = t >> 6; ci = t & 63; rs = r - 4; rs = rs < 0 ? 0 : (rs > 56 ? 56 : rs); cs = ci - 8; cs = cs < 0 ? 0 : (cs > 48 ? 48 : cs); }
        u32x4 qp[8];
        { const bf16* qptr = P + (size_t)row * INW + 1024 + h * 64;
#pragma unroll
          for (int j = 0; j < 8; ++j) qp[j] = *(const u32x4*)(qptr + 8 * j); }
        float sc[6];
#pragma unroll
        for (int kb = 0; kb < 6; ++kb) {
            int krow; float bias = 0.f; bool valid = true;
            if (kb < 2) { const int i = kb * 64 + c.lane, jr = i >> 4, jc = i & 15, kr = rs + jr, kc = cs + jc;
                krow = b * SEQ + kr * 64 + kc; bias = rpb[(h * 15 + (kr - r + 7)) * 31 + (kc - ci + 15)]; valid = lat; if (!lat) krow = row; }
            else krow = NLAT + b * CTXL + (kb - 2) * 64 + c.lane;
            const bf16* kp = P + (size_t)krow * INW + 1280 + h * 64; float s = 0.f;
#pragma unroll
            for (int j = 0; j < 8; ++j) { const u32x4 w = *(const u32x4*)(kp + 8 * j);
#pragma unroll
                for (int q = 0; q < 4; ++q) s += bf2f(qp[j][q] & 0xffffu) * bf2f(w[q] & 0xffffu) + bf2f(qp[j][q] >> 16) * bf2f(w[q] >> 16); }
            sc[kb] = valid ? s + bias : -1e30f;
        }
        float mx = sc[0];
#pragma unroll
        for (int kb = 1; kb < 6; ++kb) mx = fmaxf(mx, sc[kb]);
        mx = wave_max(mx);
        float sum = 0.f;
#pragma unroll
        for (int kb = 0; kb < 6; ++kb) { sc[kb] = __expf(sc[kb] - mx); sum += sc[kb]; }
        sum = wave_sum(sum); const float inv = 1.f / sum;
#pragma unroll
        for (int kb = 0; kb < 6; ++kb) pw[kb * 64 + c.lane] = sc[kb] * inv;
        asm volatile("s_waitcnt lgkmcnt(0)" ::: "memory");
        float o = 0.f;
        if (lat) {
            for (int i = 0; i < 128; ++i) { const int krow = b * SEQ + (rs + (i >> 4)) * 64 + cs + (i & 15); o += pw[i] * bf2f(P[(size_t)krow * INW + 1536 + h * 64 + c.lane]); }
        }
        for (int i = 0; i < 256; ++i) { const int krow = NLAT + b * CTXL + i; o += pw[128 + i] * bf2f(P[(size_t)krow * INW + 1536 + h * 64 + c.lane]); }
        br[(size_t)row * D + 768 + h * 64 + c.lane] = (bf16)f2bf(o);
        asm volatile("s_waitcnt lgkmcnt(0)" ::: "memory");
    }
}

__device__ __forceinline__ void phase_attn_mfma(const Ctx& c_in, int l, bool with_ctx_q) {
    LAUNDER(c_in);
    const Args& a = *c.a;
    const bf16* P = (const bf16*)(c.ws + WS_P); const bf16* VT2 = (const bf16*)(c.ws + WS_VT2); bf16* br = (bf16*)(c.ws + WS_BR);
    LAS float* rl = (LAS float*)c.lds;
    __syncthreads();
    for (int i = c.tid; i < 4 * 15 * 31; i += 512) rl[i] = a.in[I_RPB][(size_t)l * 4 * 15 * 31 + i];
    __syncthreads();
    const int nunits = 4096 + (with_ctx_q ? 256 : 0);
    const int q = c.lane & 15, fq = c.lane >> 4;
    for (int un = c.gw; un < nunits; un += c.NGW) {
        const bool lat = un < 4096;
        int h, b, qrow0, r = 0, c0 = 0, rs = 0, cw = 0;
        if (lat) { h = un & 3; const int j = (un >> 2) & 3; r = (un >> 4) & 63; b = un >> 10; c0 = 16 * j; cw = j == 0 ? 0 : (j == 1 ? 8 : (j == 2 ? 24 : 32));
                   rs = r - 4; rs = rs < 0 ? 0 : (rs > 56 ? 56 : rs); qrow0 = b * SEQ + r * 64 + c0; }
        else { const int v = un - 4096; h = v & 3; b = v >> 6; qrow0 = NLAT + b * CTXL + ((v >> 2) & 15) * 16; }
        bf16x8 qf[2];
#pragma unroll
        for (int kk = 0; kk < 2; ++kk) qf[kk] = *(const bf16x8*)(P + (size_t)(qrow0 + q) * INW + 1024 + h * 64 + 32 * kk + 8 * fq);
        f32x4 S[32];
        const int koff = 8 * (q >> 2) + (q & 3);
        const int ci = c0 + q; int cs = ci - 8; cs = cs < 0 ? 0 : (cs > 48 ? 48 : cs);
        if (lat) {
#pragma unroll
            for (int tb = 0; tb < 16; tb += 8) {
                bf16x8 kf[8][2];
#pragma unroll
                for (int u = 0; u < 8; ++u) { const int t = tb + u, blk = t >> 1, sOdd = t & 1;
                    const bf16* kp = P + (size_t)(b * SEQ + (rs + blk) * 64 + cw + koff + 4 * sOdd) * INW + 1280 + h * 64 + 8 * fq;
                    kf[u][0] = *(const bf16x8*)kp; kf[u][1] = *(const bf16x8*)(kp + 32); }
#pragma unroll
                for (int u = 0; u < 8; ++u) { const int t = tb + u, blk = t >> 1, sOdd = t & 1;
                    f32x4 acc = (f32x4){0.f, 0.f, 0.f, 0.f};
                    acc = __builtin_amdgcn_mfma_f32_16x16x32_bf16(kf[u][0], qf[0], acc, 0, 0, 0);
                    acc = __builtin_amdgcn_mfma_f32_16x16x32_bf16(kf[u][1], qf[1], acc, 0, 0, 0);
                    const LAS float* bp = rl + (h * 15 + (rs + blk - r + 7)) * 31 + 15 - ci;
#pragma unroll
                    for (int i = 0; i < 4; ++i) { const int kc = cw + 8 * fq + 4 * sOdd + i; const bool ok = kc >= cs && kc < cs + 16;
                        acc[i] = ok ? acc[i] + bp[ok ? kc : ci] : -1e30f; }
                    S[t] = acc; }
            }
        } else {
#pragma unroll
            for (int t = 0; t < 16; ++t) S[t] = (f32x4){-1e30f, -1e30f, -1e30f, -1e30f};
        }
#pragma unroll
        for (int tb = 16; tb < 32; tb += 8) {
            bf16x8 kf[8][2];
#pragma unroll
            for (int u = 0; u < 8; ++u) { const int t = tb + u, blk = (t >> 1) - 8, sOdd = t & 1;
                const bf16* kp = P + (size_t)(NLAT + b * CTXL + blk * 32 + koff + 4 * sOdd) * INW + 1280 + h * 64 + 8 * fq;
                kf[u][0] = *(const bf16x8*)kp; kf[u][1] = *(const bf16x8*)(kp + 32); }
#pragma unroll
            for (int u = 0; u < 8; ++u) { f32x4 acc = (f32x4){0.f, 0.f, 0.f, 0.f};
                acc = __builtin_amdgcn_mfma_f32_16x16x32_bf16(kf[u][0], qf[0], acc, 0, 0, 0);
                acc = __builtin_amdgcn_mfma_f32_16x16x32_bf16(kf[u][1], qf[1], acc, 0, 0, 0);
                S[tb + u] = acc; }
        }
        float mx = -1e30f;
#pragma unroll
        for (int t = 0; t < 32; ++t) mx = fmaxf(mx, fmaxf(fmaxf(S[t][0], S[t][1]), fmaxf(S[t][2], S[t][3])));
        mx = fmaxf(mx, SWZ_XOR(mx, 16));
        mx = fmaxf(mx, __builtin_bit_cast(float, __builtin_amdgcn_ds_bpermute((c.lane ^ 32) << 2, __builtin_bit_cast(int, mx))));
        float sum = 0.f;
#pragma unroll
        for (int t = 0; t < 32; ++t)
#pragma unroll
            for (int i = 0; i < 4; ++i) { const float e = __expf(S[t][i] - mx); S[t][i] = e; sum += e; }
        sum += SWZ_XOR(sum, 16);
        sum += __builtin_bit_cast(float, __builtin_amdgcn_ds_bpermute((c.lane ^ 32) << 2, __builtin_bit_cast(int, sum)));
        const float inv = __builtin_amdgcn_rcpf(sum);
        f32x4 O[4];
#pragma unroll
        for (int dt = 0; dt < 4; ++dt) O[dt] = (f32x4){0.f, 0.f, 0.f, 0.f};
#pragma unroll
        for (int bb = 0; bb < 16; bb += 4) {
            if (bb < 8 && !lat) continue;
            bf16x8 vb[4][4];
#pragma unroll
            for (int u = 0; u < 4; ++u) { const int blk = bb + u;
                const int tok0 = blk < 8 ? (b * SEQ + (rs + blk) * 64 + cw) : (NLAT + b * CTXL + (blk - 8) * 32);
#pragma unroll
                for (int dt = 0; dt < 4; ++dt) vb[u][dt] = *(const bf16x8*)(VT2 + (size_t)(h * 64 + 16 * dt + q) * MT + tok0 + 8 * fq); }
#pragma unroll
            for (int u = 0; u < 4; ++u) { const int blk = bb + u;
                u32x4 pw; pw.x = pk2(S[2 * blk][0] * inv, S[2 * blk][1] * inv); pw.y = pk2(S[2 * blk][2] * inv, S[2 * blk][3] * inv);
                pw.z = pk2(S[2 * blk + 1][0] * inv, S[2 * blk + 1][1] * inv); pw.w = pk2(S[2 * blk + 1][2] * inv, S[2 * blk + 1][3] * inv);
                const bf16x8 pa = __builtin_bit_cast(bf16x8, pw);
#pragma unroll
                for (int dt = 0; dt < 4; ++dt) O[dt] = __builtin_amdgcn_mfma_f32_16x16x32_bf16(pa, vb[u][dt], O[dt], 0, 0, 0); }
        }
#pragma unroll
        for (int dt = 0; dt < 4; ++dt)
#pragma unroll
            for (int i = 0; i < 4; ++i) br[(size_t)(qrow0 + 4 * fq + i) * D + 768 + h * 64 + 16 * dt + q] = (bf16)f2bf(O[dt][i]);
    }
    __syncthreads();
}
__device__ __forceinline__ void phase_attn_lds(const Ctx& c_in, int l, bool with_ctx_q) {
    LAUNDER(c_in);
    const Args& a = *c.a;
    const bf16* P = (const bf16*)(c.ws + WS_P); const bf16* VT2 = (const bf16*)(c.ws + WS_VT2); bf16* br = (bf16*)(c.ws + WS_BR);
    LAS float* rl = (LAS float*)c.lds;
    __syncthreads();
    for (int i = c.tid; i < 4 * 15 * 31; i += 512) rl[i] = a.in[I_RPB][(size_t)l * 4 * 15 * 31 + i];
    __syncthreads();
    const int q = c.lane & 15, fq = c.lane >> 4;
    const int bh = c.bid >> 4, sgrp = c.bid & 15, b = bh >> 2, h = bh & 3;
    LAS bf16* Kc = (LAS bf16*)(c.lds + 8192); LAS bf16* Vc = (LAS bf16*)(c.lds + 8192 + 36864);
    for (int i = c.tid; i < 256 * 8; i += 512) { const int key = i >> 3, pc = i & 7;
        *(LAS u32x4*)(Kc + key * 72 + pc * 8) = *(const u32x4*)(P + (size_t)(NLAT + b * CTXL + key) * INW + 1280 + h * 64 + pc * 8); }
    for (int i = c.tid; i < 64 * 32; i += 512) { const int d = i >> 5, pc = i & 31;
        *(LAS u32x4*)(Vc + d * 264 + pc * 8) = *(const u32x4*)(VT2 + (size_t)(h * 64 + d) * MT + NLAT + b * CTXL + pc * 8); }
    __syncthreads();
    for (int it = 0; it < 3; ++it) {
        const bool lat = it < 2;
        if (!lat && (!with_ctx_q || c.wid != 0)) break;
        int qrow0, r = 0, c0 = 0, rs = 0, cw = 0;
        if (lat) { const int u_ = (it * 16 + sgrp) * 8 + c.wid; const int j = u_ & 3; r = u_ >> 2; c0 = 16 * j; cw = j == 0 ? 0 : (j == 1 ? 8 : (j == 2 ? 24 : 32));
                   rs = r - 4; rs = rs < 0 ? 0 : (rs > 56 ? 56 : rs); qrow0 = b * SEQ + r * 64 + c0; }
        else qrow0 = NLAT + b * CTXL + sgrp * 16;
        bf16x8 qf[2];
#pragma unroll
        for (int kk = 0; kk < 2; ++kk) qf[kk] = *(const bf16x8*)(P + (size_t)(qrow0 + q) * INW + 1024 + h * 64 + 32 * kk + 8 * fq);
        f32x4 S[32];
        const int koff = 8 * (q >> 2) + (q & 3);
        const int ci = c0 + q; int cs = ci - 8; cs = cs < 0 ? 0 : (cs > 48 ? 48 : cs);
        if (lat) {
#pragma unroll
            for (int tb = 0; tb < 16; tb += 8) {
                bf16x8 kf[8][2];
#pragma unroll
                for (int u = 0; u < 8; ++u) { const int t = tb + u, blk = t >> 1, sOdd = t & 1;
                    const bf16* kp = P + (size_t)(b * SEQ + (rs + blk) * 64 + cw + koff + 4 * sOdd) * INW + 1280 + h * 64 + 8 * fq;
                    kf[u][0] = *(const bf16x8*)kp; kf[u][1] = *(const bf16x8*)(kp + 32); }
#pragma unroll
                for (int u = 0; u < 8; ++u) { const int t = tb + u, blk = t >> 1, sOdd = t & 1;
                    f32x4 acc = (f32x4){0.f, 0.f, 0.f, 0.f};
                    acc = __builtin_amdgcn_mfma_f32_16x16x32_bf16(kf[u][0], qf[0], acc, 0, 0, 0);
                    acc = __builtin_amdgcn_mfma_f32_16x16x32_bf16(kf[u][1], qf[1], acc, 0, 0, 0);
                    const LAS float* bp = rl + (h * 15 + (rs + blk - r + 7)) * 31 + 15 - ci;
#pragma unroll
                    for (int i = 0; i < 4; ++i) { const int kc = cw + 8 * fq + 4 * sOdd + i; const bool ok = kc >= cs && kc < cs + 16;
                        acc[i] = ok ? acc[i] + bp[ok ? kc : ci] : -1e30f; }
                    S[t] = acc; }
            }
        } else {
#pragma unroll
            for (int t = 0; t < 16; ++t) S[t] = (f32x4){-1e30f, -1e30f, -1e30f, -1e30f};
        }
#pragma unroll
        for (int tb = 16; tb < 32; tb += 8) {
            bf16x8 kf[8][2];
#pragma unroll
            for (int u = 0; u < 8; ++u) { const int t = tb + u, blk = (t >> 1) - 8, sOdd = t & 1;
                const LAS bf16* kp = Kc + (blk * 32 + koff + 4 * sOdd) * 72 + 8 * fq;
                kf[u][0] = *(const LAS bf16x8*)kp; kf[u][1] = *(const LAS bf16x8*)(kp + 32); }
#pragma unroll
            for (int u = 0; u < 8; ++u) { f32x4 acc = (f32x4){0.f, 0.f, 0.f, 0.f};
                acc = __builtin_amdgcn_mfma_f32_16x16x32_bf16(kf[u][0], qf[0], acc, 0, 0, 0);
                acc = __builtin_amdgcn_mfma_f32_16x16x32_bf16(kf[u][1], qf[1], acc, 0, 0, 0);
                S[tb + u] = acc; }
        }
        float mx = -1e30f;
#pragma unroll
        for (int t = 0; t < 32; ++t) mx = fmaxf(mx, fmaxf(fmaxf(S[t][0], S[t][1]), fmaxf(S[t][2], S[t][3])));
        mx = fmaxf(mx, SWZ_XOR(mx, 16));
        mx = fmaxf(mx, __builtin_bit_cast(float, __builtin_amdgcn_ds_bpermute((c.lane ^ 32) << 2, __builtin_bit_cast(int, mx))));
        float sum = 0.f;
#pragma unroll
        for (int t = 0; t < 32; ++t)
#pragma unroll
            for (int i = 0; i < 4; ++i) { const float e = __expf(S[t][i] - mx); S[t][i] = e; sum += e; }
        sum += SWZ_XOR(sum, 16);
        sum += __builtin_bit_cast(float, __builtin_amdgcn_ds_bpermute((c.lane ^ 32) << 2, __builtin_bit_cast(int, sum)));
        const float inv = __builtin_amdgcn_rcpf(sum);
        f32x4 O[4];
#pragma unroll
        for (int dt = 0; dt < 4; ++dt) O[dt] = (f32x4){0.f, 0.f, 0.f, 0.f};
#pragma unroll
        for (int bb = 0; bb < 16; bb += 4) {
            if (bb < 8 && !lat) continue;
            bf16x8 vb[4][4];
#pragma unroll
            for (int u = 0; u < 4; ++u) { const int blk = bb + u;
                if (blk < 8) { const int tok0 = b * SEQ + (rs + blk) * 64 + cw;
#pragma unroll
                    for (int dt = 0; dt < 4; ++dt) vb[u][dt] = *(const bf16x8*)(VT2 + (size_t)(h * 64 + 16 * dt + q) * MT + tok0 + 8 * fq); }
                else {
#pragma unroll
                    for (int dt = 0; dt < 4; ++dt) vb[u][dt] = *(const LAS bf16x8*)(Vc + (16 * dt + q) * 264 + (blk - 8) * 32 + 8 * fq); } }
#pragma unroll
            for (int u = 0; u < 4; ++u) { const int blk = bb + u;
                u32x4 pw; pw.x = pk2(S[2 * blk][0] * inv, S[2 * blk][1] * inv); pw.y = pk2(S[2 * blk][2] * inv, S[2 * blk][3] * inv);
                pw.z = pk2(S[2 * blk + 1][0] * inv, S[2 * blk + 1][1] * inv); pw.w = pk2(S[2 * blk + 1][2] * inv, S[2 * blk + 1][3] * inv);
                const bf16x8 pa = __builtin_bit_cast(bf16x8, pw);
#pragma unroll
                for (int dt = 0; dt < 4; ++dt) O[dt] = __builtin_amdgcn_mfma_f32_16x16x32_bf16(pa, vb[u][dt], O[dt], 0, 0, 0); }
        }
#pragma unroll
        for (int dt = 0; dt < 4; ++dt)
#pragma unroll
            for (int i = 0; i < 4; ++i) br[(size_t)(qrow0 + 4 * fq + i) * D + 768 + h * 64 + 16 * dt + q] = (bf16)f2bf(O[dt][i]);
    }
    __syncthreads();
}
__device__ __forceinline__ void phase_s5_carry(const Ctx& c_in, int l) {
    LAUNDER(c_in);
    if (c.gw >= 128) return;
    const int b = c.gw >> 5, g = (c.gw >> 1) & 15, dir = c.gw & 1, n = c.lane;
    const float* a16 = (const float*)(c.ws + WS_A16) + (((size_t)(l * 2 + dir) * 16 + g) * 64 + n) * 2;
    const float ar = a16[0], ai = a16[1];
    const float* sst = (const float*)(c.ws + WS_SST); bf16* ac = (bf16*)(c.ws + WS_ACAT);
    float hr = 0.f, hi = 0.f;
    for (int i0 = 0; i0 < 272; i0 += 16) {
        float sr[16], si[16]; int ao[16];
#pragma unroll
        for (int j = 0; j < 16; ++j) {
            const int i = i0 + j; int ch;
            if (dir == 0) ch = i < 16 ? (NLAT / 16 + b * 16 + i) : (b * 256 + (i - 16));
            else          ch = i < 16 ? (NLAT / 16 + b * 16 + (15 - i)) : (b * 256 + (255 - (i - 16)));
            const int so = (ch * 16 + g) * 256 + dir * 128 + n; ao[j] = (ch * 16 + g) * 512 + 256 + dir * 128 + n;
            sr[j] = sst[so]; si[j] = sst[so + 64];
        }
#pragma unroll
        for (int j = 0; j < 16; ++j) {
            ac[ao[j]] = (bf16)f2bf(hr); ac[ao[j] + 64] = (bf16)f2bf(hi);
            const float nr = ar * hr - ai * hi + sr[j], ni = ar * hi + ai * hr + si[j]; hr = nr; hi = ni;
        }
    }
}

__device__ __forceinline__ void phase_n2(const Ctx& c_in, int l) {
    LAUNDER(c_in);
    const Args& a = *c.a; unsigned char* ws = c.ws;
    const int nrows = (l == DEPTH - 1) ? NLAT : MT;
    LAS unsigned char* hb = c.lds + c.wid * N2_SLOT;
    LAS float* lgs = (LAS float*)(c.lds + LDS_MISC + 2048) + c.wid * 128;
    const u32x4* rwf = (const u32x4*)(ws + WS_RWF) + (size_t)l * 64 * 128;
    const float* rw = a.in[I_RW] + (size_t)l * D * NEXP; const float* rb = a.in[I_RB] + l * NEXP;
    unsigned* cnt = (unsigned*)(ws + WS_CTL) + CW_CNT + l * 32 * 64;
    LAS unsigned* lcnt = (LAS unsigned*)(c.lds + LDS_MISC + 1024);
    __syncthreads();
    if (c.tid < 64) lcnt[c.tid] = 0u;
    __syncthreads();
    u32x4 wf[4][2][2];
#pragma unroll
    for (int u = 0; u < 4; ++u)
#pragma unroll
        for (int nb = 0; nb < 2; ++nb)
#pragma unroll
            for (int p = 0; p < 2; ++p) wf[u][nb][p] = rwf[(size_t)(((c.wid * 4 + u) * 2 + nb) * 2 + p) * 64 + c.lane];
    for (int grp = c.gw; grp < nrows / 4; grp += c.NGW) {
        f32x4 yy[4][4], xx[4][4];
#pragma unroll
        for (int tk = 0; tk < 4; ++tk) { const int row = grp * 4 + tk; load_row_bf((const bf16*)(ws + WS_Y) + (size_t)row * D, c.lane, yy[tk]);
            if (l == 0) load_row(xin_row(a, row), c.lane, xx[tk]); else load_row_bf((const bf16*)(ws + WS_XS) + (size_t)row * D, c.lane, xx[tk]); }
#pragma unroll
        for (int tk = 0; tk < 4; ++tk) {
            const int row = grp * 4 + tk;
            f32x4 (&y)[4] = yy[tk]; f32x4 (&x)[4] = xx[tk];
            const float r = row_rms_scale(y);
            const float* gm = mod_ptr(ws, l, row, 2);
#pragma unroll
            for (int j = 0; j < 4; ++j) { const int o = 4 * c.lane + 256 * j; const f32x4 g = *(const f32x4*)(a.in[I_NMPOST] + l * D + o), m = *(const f32x4*)(gm + o);
                x[j] = x[j] + m * (y[j] * r * g); st_bf4((bf16*)(ws + WS_XS) + (size_t)row * D + o, x[j]); }
            norm_mod_split(x, a.in[I_NFPRE] + l * D, mod_ptr(ws, l, row, 3), mod_ptr(ws, l, row, 4), c.lane, hb + tk * N2_RS);
        }
        asm volatile("s_waitcnt lgkmcnt(0)" ::: "memory");
        const int e = c.lane & 31;
        u32x4 f8r[4];
#pragma unroll
        for (int tk = 0; tk < 4; ++tk) {
            const LAS u32x4* hp = (const LAS u32x4*)(hb + tk * N2_RS + 32 * c.lane); const LAS u32x4* lp = (const LAS u32x4*)(hb + N2_LO + tk * N2_RS + 32 * c.lane);
            const u32x4 a0 = hp[0], a1 = hp[1], b0 = lp[0], b1 = lp[1]; u32x4 f;
#define H2V(av, bv, q) (bf2f(av & 0xffffu) + bf2f(bv & 0xffffu)) * F8_X, (bf2f(av >> 16) + bf2f(bv >> 16)) * F8_X
            f.x = pk4_fp8(H2V(a0.x, b0.x, 0), H2V(a0.y, b0.y, 0)); f.y = pk4_fp8(H2V(a0.z, b0.z, 0), H2V(a0.w, b0.w, 0));
            f.z = pk4_fp8(H2V(a1.x, b1.x, 0), H2V(a1.y, b1.y, 0)); f.w = pk4_fp8(H2V(a1.z, b1.z, 0), H2V(a1.w, b1.w, 0));
#undef H2V
            f8r[tk] = f;
        }
        __syncthreads();
        {
            const int kq = c.lane >> 4;
            f32x4 acc[2][2];
#pragma unroll
            for (int tt = 0; tt < 2; ++tt)
#pragma unroll
                for (int nb = 0; nb < 2; ++nb) acc[tt][nb] = (f32x4){0.f, 0.f, 0.f, 0.f};
#pragma unroll
            for (int tt = 0; tt < 2; ++tt) {
                const int tok = 16 * tt + (c.lane & 15);
                const LAS unsigned char* ap = c.lds + (tok >> 2) * N2_SLOT + (tok & 3) * N2_RS + (c.wid * 4) * 64 + kq * 16;
#pragma unroll
                for (int u = 0; u < 4; ++u) {
                    const bf16x8 ah = *(const LAS bf16x8*)(ap + u * 64), al = *(const LAS bf16x8*)(ap + N2_LO + u * 64);
#pragma unroll
                    for (int nb = 0; nb < 2; ++nb) {
                        const bf16x8 wh = __builtin_bit_cast(bf16x8, wf[u][nb][0]), wl = __builtin_bit_cast(bf16x8, wf[u][nb][1]);
                        acc[tt][nb] = __builtin_amdgcn_mfma_f32_16x16x32_bf16(wh, ah, acc[tt][nb], 0, 0, 0);
                        acc[tt][nb] = __builtin_amdgcn_mfma_f32_16x16x32_bf16(wh, al, acc[tt][nb], 0, 0, 0);
                        acc[tt][nb] = __builtin_amdgcn_mfma_f32_16x16x32_bf16(wl, ah, acc[tt][nb], 0, 0, 0);
                    }
                }
            }
            asm volatile("s_waitcnt lgkmcnt(0)" ::: "memory");
            __syncthreads();
            LAS float* pp = (LAS float*)c.lds + c.wid * 1024;
#pragma unroll
            for (int tt = 0; tt < 2; ++tt)
#pragma unroll
                for (int nb = 0; nb < 2; ++nb) *(LAS f32x4*)(pp + (16 * tt + (c.lane & 15)) * 32 + 16 * nb + 4 * kq) = acc[tt][nb];
            asm volatile("s_waitcnt lgkmcnt(0)" ::: "memory");
            __syncthreads();
        }
        int myek = 0; float mywk = 0.f;
#pragma unroll
        for (int tk = 0; tk < 4; ++tk) {
            float v = rb[e];
#pragma unroll
            for (int w_ = 0; w_ < 8; ++w_) v += ((const LAS float*)c.lds)[w_ * 1024 + (4 * c.wid + tk) * 32 + e];
            float tv[4]; int ti[4];
#pragma unroll
            for (int k = 0; k < 4; ++k) {
                float bv = v; int bi = e;
#define ARGMAX_STEP(o) { const float ov = SWZ_XOR(bv, o); const int oi = SWZ_XOR_I(bi, o); if (ov > bv || (ov == bv && oi < bi)) { bv = ov; bi = oi; } }
                ARGMAX_STEP(1) ARGMAX_STEP(2) ARGMAX_STEP(4) ARGMAX_STEP(8) ARGMAX_STEP(16)
#undef ARGMAX_STEP
                tv[k] = bv; ti[k] = bi; if (e == bi) v = -3.0e38f;
            }
            const float e1 = __expf(tv[1] - tv[0]), e2 = __expf(tv[2] - tv[0]), e3 = __expf(tv[3] - tv[0]), inv = 1.f / (1.f + e1 + e2 + e3);
            const int k = c.lane & 3; const bool mine = (c.lane >> 2) == tk;
            const int ek = k == 0 ? ti[0] : (k == 1 ? ti[1] : (k == 2 ? ti[2] : ti[3]));
            const float wk = (k == 0 ? 1.f : (k == 1 ? e1 : (k == 2 ? e2 : e3))) * inv;
            myek = mine ? ek : myek; mywk = mine ? wk : mywk;
        }
        unsigned lidx = 0u;
        if (c.lane < 16) lidx = __hip_atomic_fetch_add(lcnt + myek, 1u, __ATOMIC_RELAXED, __HIP_MEMORY_SCOPE_WORKGROUP);
        __syncthreads();
        if (c.wid == 0 && c.lane < NEXP) { const unsigned n_ = lcnt[c.lane]; lcnt[32 + c.lane] = n_ ? atomicAdd(cnt + c.lane * 64, n_) : 0u; lcnt[c.lane] = 0u; }
        __syncthreads();
        int dst16 = 0;
        if (c.lane < 16) {
            const int idx = grp * 16 + c.lane;
            const unsigned slot = lcnt[32 + myek] + lidx;
            ((int*)(ws + WS_RE))[idx] = myek; ((int*)(ws + WS_RS))[idx] = (int)slot; ((float*)(ws + WS_RW))[idx] = mywk;
            dst16 = myek * MOE_CAP + (int)slot;
        }
#pragma unroll
        for (int tk = 0; tk < 4; ++tk) {
#pragma unroll
            for (int k = 0; k < 4; ++k) { const int dr = __builtin_amdgcn_readlane(dst16, 4 * tk + k);
                *(u32x4*)((unsigned char*)(ws + WS_XB) + (size_t)dr * D + 16 * c.lane) = f8r[tk]; }
        }
        asm volatile("s_waitcnt lgkmcnt(0)" ::: "memory");
    }
}

constexpr int LDS_TS = LDS_MISC + 1024;
__device__ __forceinline__ void moe_prefix(const Ctx& c_in, int l) {
    LAUNDER(c_in);
    LAS int* ts = (LAS int*)(c.lds + LDS_TS);
    unsigned* cnt = (unsigned*)(c.ws + WS_CTL) + CW_CNT + l * 32 * 64;
    __syncthreads();
    if (c.tid < NEXP) ts[64 + c.tid] = ((int)xb_ld(cnt + c.tid * 64) + 255) >> 8;
    __syncthreads();
    if (c.tid == 0) { int s_ = 0; for (int e = 0; e < NEXP; ++e) { ts[e] = s_; s_ += ts[64 + e]; } ts[32] = s_; }
    __syncthreads();
}
__device__ __forceinline__ void phase_comb(const Ctx& c_in, int l) {
    LAUNDER(c_in);
    const Args& a = *c.a; unsigned char* ws = c.ws;
    const bool last = (l == DEPTH - 1);
    const int nrows = last ? NLAT : MT;
    const bf16* YB = (const bf16*)(ws + WS_YB);
    const LAS int* ts = (const LAS int*)(c.lds + LDS_TS);
    for (int row0 = c.gw * 2; row0 < nrows; row0 += c.NGW * 2) {
        int dest[2][4]; float wk[2][4];
#pragma unroll
        for (int u = 0; u < 2; ++u)
#pragma unroll
            for (int k = 0; k < 4; ++k) { const int e_ = ((const int*)(ws + WS_RE))[(row0 + u) * 4 + k], sl = ((const int*)(ws + WS_RS))[(row0 + u) * 4 + k];
                dest[u][k] = ts[e_] * 256 + sl; wk[u][k] = ((const float*)(ws + WS_RW))[(row0 + u) * 4 + k]; }
        unsigned yb[2][4][4]; f32x4 xr[2][4];
#pragma unroll
        for (int u = 0; u < 2; ++u) {
#pragma unroll
            for (int k = 0; k < 4; ++k)
#pragma unroll
                for (int j = 0; j < 4; ++j) yb[u][k][j] = *(const unsigned*)((const unsigned char*)YB + (size_t)dest[u][k] * D + 4 * c.lane + 256 * j);
            load_row_bf((const bf16*)(ws + WS_XS) + (size_t)(row0 + u) * D, c.lane, xr[u]);
        }
#pragma unroll
        for (int u = 0; u < 2; ++u) {
            const int row = row0 + u;
            f32x4 y[4];
#pragma unroll
            for (int j = 0; j < 4; ++j) y[j] = (f32x4){0.f, 0.f, 0.f, 0.f};
#pragma unroll
            for (int k = 0; k < 4; ++k)
#pragma unroll
                for (int j = 0; j < 4; ++j) { const int v = (int)yb[u][k][j];
                    const f32x2 lo = __builtin_amdgcn_cvt_pk_f32_fp8(v, false), hi = __builtin_amdgcn_cvt_pk_f32_fp8(v, true);
                    y[j] += (f32x4){lo.x, lo.y, hi.x, hi.y} * (wk[u][k] * (1.f / F8_Y)); }
            f32x4 (&x)[4] = xr[u];
            const float r = row_rms_scale(y);
            const float* gf = mod_ptr(ws, l, row, 5);
#pragma unroll
            for (int j = 0; j < 4; ++j) { const int o = 4 * c.lane + 256 * j; const f32x4 g = *(const f32x4*)(a.in[I_NFPOST] + l * D + o), m = *(const f32x4*)(gf + o);
                x[j] = x[j] + m * (y[j] * r * g);
                if (last) *(f32x4*)(a.out + (size_t)row * D + o) = x[j]; else st_bf4((bf16*)(ws + WS_XS) + (size_t)row * D + o, x[j]); }
            if (!last) norm_mod_store<false, true, true>(x, a.in[I_NMPRE] + (l + 1) * D, mod_ptr(ws, l + 1, row, 0), mod_ptr(ws, l + 1, row, 1), (bf16*)(ws + WS_H) + (size_t)row * D, c.lane, nullptr, ws + WS_H8 + (size_t)row * D);
        }
    }
}

constexpr int NPHASE = 2 + 12 * DEPTH;
#ifndef ONLY_PH
#define ONLY_PH -1
#endif
#define PHASE(k, ...) if constexpr (ONLY_PH < 0 || (k) == ONLY_PH) if (args.ph_lo <= (k) && (k) < args.ph_hi) { __VA_ARGS__; if ((k) + 1 < args.ph_hi) xcd_barrier(bar); }
template <int L>
__device__ __forceinline__ void layer_phases(const Ctx& c, const Args& args, const XcdBarrier& bar) {
    constexpr int l = L, base = 2 + 12 * L;
    unsigned char* ws = c.ws;
    PHASE(base + 0, {
        const int nMf_ = (l == DEPTH - 1) ? NLAT / 256 : MT / 256, Uw_ = (MT / 256) * 7;
        EpiG1 E{ws, args.in[I_BBG] + (size_t)l * 4096, (const float*)(ws + WS_ROPE)};
        { SchedG1 S{(const char*)(ws + WS_H), (const char*)(ws + WS_WINT) + (size_t)l * NG1 * D * 2, MT / 256, nMf_, NG1 / 256, 7, c.G, c.bid, 0, Uw_};
          run_gemm(c.lds, ws + WS_END, pg8::Gemm{D, D, D}, S, E); __syncthreads(); }
        { SchedGate S{(const char*)(ws + WS_H8), (const char*)(ws + WS_WBG8) + (size_t)l * 4096 * D, nMf_, c.G, c.bid, Uw_ % c.G};
          run_gemm<EpiG1, SchedGate, true, 0, true>(c.lds, ws + WS_END, pg8::Gemm{D / 2, D / 2, D / 2, F8_SC_W, F8_SC_X}, S, E); __syncthreads(); } })
    PHASE(base + 1, {
        SchedS5 S{(const char*)(ws + WS_ACAT), (const char*)(ws + WS_BT1) + (size_t)l * 16 * 256 * 256 * 2, 256, c.G, c.bid};
        EpiS1 E{(float*)(ws + WS_SST)};
        for (int r_ = 0; r_ < REP_S5; ++r_) { run_gemm(c.lds, ws + WS_END, pg8::Gemm{8192, 256, 256}, S, E); __syncthreads(); } })
    PHASE(base + 2, {
        phase_s5_carry(c, l);
        __syncthreads();
        { Ctx c2 = c; c2.brot = 16;
          for (int r_ = 0; r_ < REP_GLN; ++r_) phase_gmlp_ln(c2, l);
          for (int r_ = 0; r_ < REP_POOL; ++r_) phase_pool(c2, l);
          for (int r_ = 0; r_ < REP_ATT; ++r_) { if (c.G == 256) phase_attn_lds(c2, l, l != DEPTH - 1); else phase_attn_mfma(c2, l, l != DEPTH - 1); } } })
    PHASE(base + 3, {
#ifdef S5_NAIVE
        dbg_s5_readout(c, l);
#else
        { SchedS5 S{(const char*)(ws + WS_ACAT), (const char*)(ws + WS_BT3) + (size_t)l * 16 * 256 * 512 * 2, 512, c.G, c.bid};
          EpiS3 E{(bf16*)(ws + WS_YG)};
          for (int r_ = 0; r_ < REP_S5; ++r_) { run_gemm(c.lds, ws + WS_END, pg8::Gemm{8192, 512, 512}, S, E); __syncthreads(); } }
#endif
        __syncthreads();
        { SchedGM S{(const char*)(ws + WS_VT), (const char*)(ws + WS_WST) + (size_t)l * 4 * 256 * 128 * 2, c.G, c.G >= 216 ? c.bid - 80 : c.bid};
          EpiGM E{(const bf16*)(ws + WS_P), (bf16*)(ws + WS_BR), args.in[I_GBS] + (size_t)l * 512};
          for (int r_ = 0; r_ < REP_S5; ++r_) { run_gemm(c.lds, ws + WS_END, pg8::Gemm{128, 128, 128}, S, E); __syncthreads(); } } })
    PHASE(base + 4, {
        if (c.G >= 200 && c.bid >= 136) {
            const int nr_ = (l == DEPTH - 1) ? NLAT : MT;
            const int nw_ = (c.G - 136) * 8, w0_ = (c.bid - 136) * 8 + c.wid;
            for (int r0 = w0_ * 8; r0 < nr_; r0 += nw_ * 8) {
                u32x4 v[8];
                _Pragma("unroll")
                for (int u = 0; u < 8; ++u) v[u] = *(const u32x4*)((const bf16*)(ws + WS_BR) + (size_t)(r0 + u) * D + 512 + 8 * c.lane);
                _Pragma("unroll")
                for (int u = 0; u < 8; ++u) { u32x2 o;
                    o.x = pk4_fp8(bf2f(v[u].x & 0xffffu) * F8_B, bf2f(v[u].x >> 16) * F8_B, bf2f(v[u].y & 0xffffu) * F8_B, bf2f(v[u].y >> 16) * F8_B);
                    o.y = pk4_fp8(bf2f(v[u].z & 0xffffu) * F8_B, bf2f(v[u].z >> 16) * F8_B, bf2f(v[u].w & 0xffffu) * F8_B, bf2f(v[u].w >> 16) * F8_B);
                    *(u32x2*)(ws + WS_BR8 + (size_t)(r0 + u) * D + 512 + 8 * c.lane) = o; }
            }
        } else {
        PlainSched S{(const char*)(ws + WS_YG), (const char*)(ws + WS_WGLUT) + (size_t)l * 512 * 256 * 2, 256, 256, MT / 256, 2, c.G, c.bid};
        EpiGLU E{(bf16*)(ws + WS_BR8)};
        for (int r_ = 0; r_ < REP_S5; ++r_) { run_gemm(c.lds, ws + WS_END, pg8::Gemm{256, 256, 256}, S, E); __syncthreads(); } } })
    PHASE(base + 5, {
        for (int r_ = 0; r_ < REP_G2; ++r_) gemm_merge(c.lds, (const char*)(ws + WS_BR8), (const char*)(ws + WS_WBRT) + (size_t)l * 4 * D * 256, (const bf16*)(ws + WS_GATES), (bf16*)(ws + WS_MRG), (l == DEPTH - 1) ? NLAT / 256 : MT / 256, c.G, c.bid); })
    PHASE(base + 6, {
        PlainSched S{(const char*)(ws + WS_MRG), (const char*)(ws + WS_WOUTT) + (size_t)l * D * D * 2, D, D, (l == DEPTH - 1) ? NLAT / 256 : MT / 256, 4, c.G, c.bid};
        EpiBF E{(bf16*)(ws + WS_Y), D};
        for (int r_ = 0; r_ < REP_G3; ++r_) { run_gemm(c.lds, ws + WS_END, pg8::Gemm{D, D, D}, S, E); __syncthreads(); }
        if constexpr (DBG_G3 != 0) { run_gemm<decltype(E), decltype(S), false, DBG_G3>(c.lds, ws + WS_END, pg8::Gemm{D, D, D}, S, E); __syncthreads(); } })
    PHASE(base + 7, phase_n2(c, l))
    PHASE(base + 9, {
        moe_prefix(c, l);
        SchedMoE S{(const char*)(ws + WS_XB), (const char*)(ws + WS_W1T) + (size_t)l * NEXP * 2048 * D, (const LAS int*)(c.lds + LDS_TS), 8, c.G, c.bid, (size_t)2048 * D, true};
        EpiE1 E{(bf16*)(ws + WS_ACT), args.in[I_B1] + (size_t)l * NEXP * 2048}; constexpr int SCX = F8_SC_X;
        for (int r_ = 0; r_ < REP_MOE; ++r_) { run_gemm<decltype(E), decltype(S), true, 0, true>(c.lds, ws + WS_END, pg8::Gemm{D / 2, D / 2, D / 2, F8_SC_W, SCX}, S, E); __syncthreads(); }
        if constexpr (DBG_MOE != 0) { run_gemm<decltype(E), decltype(S), true, DBG_MOE>(c.lds, ws + WS_END, pg8::Gemm{D / 2, D / 2, D / 2, F8_SC_W, SCX}, S, E); __syncthreads(); } })
    PHASE(base + 10, {
        if (N_LAUNCH_MODE == 0) moe_prefix(c, l);
        SchedMoE S{(const char*)(ws + WS_ACT), (const char*)(ws + WS_W2T) + (size_t)l * NEXP * D * D, (const LAS int*)(c.lds + LDS_TS), 4, c.G, c.bid, (size_t)D * D, false};
        EpiE2 E{(bf16*)(ws + WS_YB), args.in[I_B2] + (size_t)l * NEXP * D}; constexpr int SCX = F8_SC_ACT;
        for (int r_ = 0; r_ < REP_MOE; ++r_) { run_gemm<decltype(E), decltype(S), true, 0, true>(c.lds, ws + WS_END, pg8::Gemm{D / 2, D / 2, D / 2, F8_SC_W, SCX}, S, E); __syncthreads(); }
        if constexpr (DBG_MOE != 0) { run_gemm<decltype(E), decltype(S), true, DBG_MOE>(c.lds, ws + WS_END, pg8::Gemm{D / 2, D / 2, D / 2, F8_SC_W, SCX}, S, E); __syncthreads(); } })
    PHASE(base + 11, { if (N_LAUNCH_MODE == 0) moe_prefix(c, l); phase_comb(c, l); })
}


__global__ void __launch_bounds__(512, 2) mega_fwd(Args args) {
    extern __shared__ __attribute__((aligned(16))) unsigned char lds_raw[];
    Ctx c; c.a = &args; c.ws = args.ws; c.lds = (LAS unsigned char*)lds_raw;
    c.tid = threadIdx.x; c.lane = c.tid & 63; c.wid = __builtin_amdgcn_readfirstlane(c.tid >> 6); c.brot = 0; c.G = gridDim.x; c.bid = blockIdx.x; c.gw = c.bid * 8 + c.wid; c.NGW = c.G * 8;
    unsigned char* ws = args.ws;
    volatile LAS unsigned* misc = (volatile LAS unsigned*)(c.lds + LDS_MISC);
    if (c.tid < 64) misc[c.tid] = 0u;
    __syncthreads();
    XcdBarrier bar; bar.bar = (unsigned*)(ws + WS_CTL) + CW_BAR; bar.x = 0; bar.st = misc + 8;
    const bool multi = (args.ph_hi - args.ph_lo) > 1;
    if (multi) bar = xcd_barrier_post((unsigned*)(ws + WS_CTL) + CW_BAR, misc + 8);

    PHASE(0, { for (int r_ = 0; r_ < REP_PREP; ++r_) { phase_prep(c); __syncthreads(); } })
    PHASE(1, phase_n1_layer0(c))
    layer_phases<0>(c, args, bar);
    layer_phases<1>(c, args, bar);
}

extern "C" void kernel_launch(void* const* d_in, const int* in_sizes, int n_in, void* d_out, int out_size, void* d_ws, size_t ws_size, hipStream_t stream) {
    static int grid = 0;
    if (grid == 0) {
        if (n_in != 37 || out_size != NLAT * D || ws_size < WS_END) { fprintf(stderr, "kernel_launch: unexpected shapes: n_in %d out %d ws %zu (need %zu)\n", n_in, out_size, ws_size, (size_t)WS_END); grid = -1; return; }
        int dev = 0, cus = 0;
        if (hipGetDevice(&dev) != hipSuccess || hipDeviceGetAttribute(&cus, hipDeviceAttributeMultiprocessorCount, dev) != hipSuccess) { grid = -1; return; }
        if (hipFuncSetAttribute((const void*)mega_fwd, hipFuncAttributeMaxDynamicSharedMemorySize, LDS_BYTES) != hipSuccess) { fprintf(stderr, "kernel_launch: hipFuncSetAttribute failed\n"); grid = -1; return; }
        int per_cu = 0;
        if (hipOccupancyMaxActiveBlocksPerMultiprocessor(&per_cu, (const void*)mega_fwd, 512, LDS_BYTES) != hipSuccess || per_cu < 1) fprintf(stderr, "kernel_launch: occupancy query says %d blocks/CU\n", per_cu);
        (void)hipGetLastError();
        grid = cus;
    }
    if (grid < 0) return;
    (void)hipMemsetAsync((char*)d_ws + WS_CTL, 0, CTL_BYTES, stream);
    Args a{};
    for (int i = 0; i < 37; ++i) a.in[i] = (const float*)d_in[i];
    a.out = (float*)d_out; a.ws = (unsigned char*)d_ws;
#if N_LAUNCH_MODE
    a.ph_lo = 0; a.ph_hi = NPHASE;
    hipLaunchKernelGGL(mega_fwd, dim3(grid), dim3(512), LDS_BYTES, stream, a);
#else
    for (int ph = 0; ph < NPHASE; ++ph) { a.ph_lo = ph; a.ph_hi = ph + 1; hipLaunchKernelGGL(mega_fwd, dim3(grid), dim3(512), LDS_BYTES, stream, a); }
#endif
}
```
